# Optimizing an MI355X kernel written in HIP

```python
import jax, jax.numpy as jnp
from jax import lax
import numpy as np

D_MODEL = 1024
BATCH = 4
SEQ = 8192
DEPTH = 1

HG_HEADS = 8
HG_KEY_DIM = 128
HG_VAL_DIM = D_MODEL // HG_HEADS
HG_CHUNK = 64
FOX_HEADS = 16
FOX_HEAD_DIM = 64
FOX_BLOCK = 128
FOX_F_BIAS_INIT = 2.0
D_FF = 2816
CONV_WIDTH = 3
EPS = 1e-6

HG_QK = HG_HEADS * HG_KEY_DIM
HG_V = HG_HEADS * HG_VAL_DIM
FOX_W = FOX_HEADS * FOX_HEAD_DIM
SPLITS = (HG_QK, HG_QK, HG_V, HG_V, FOX_W, FOX_W, FOX_W, FOX_HEADS, D_MODEL, D_MODEL)
D_IN = sum(SPLITS)

kernel_name = 'hgrn2_fox_gated_hybrid_block'


def rms_norm(x, g):
    xf = x.astype(jnp.float32)
    y = xf * lax.rsqrt(jnp.mean(xf * xf, axis=-1, keepdims=True) + EPS)
    return (y * g.astype(jnp.float32)).astype(x.dtype)


def hgrn2_mixer(q, f_logit, i, g, lb, g_norm):
    B, S, _ = q.shape
    n_chunks = S // HG_CHUNK
    f32 = jnp.float32
    q = jax.nn.silu(q.astype(f32))
    f = lb + (1.0 - lb) * jax.nn.sigmoid(f_logit.astype(f32))
    k = 1.0 - f
    log_f = jnp.log(f)

    def chunks(t, d):
        return t.astype(f32).reshape(B, n_chunks, HG_CHUNK, HG_HEADS, d).transpose(1, 0, 3, 2, 4)

    xs = (chunks(q, HG_KEY_DIM), chunks(k, HG_KEY_DIM), chunks(log_f, HG_KEY_DIM), chunks(i, HG_VAL_DIM))
    causal = jnp.tril(jnp.ones((HG_CHUNK, HG_CHUNK), dtype=bool))[:, :, None]

    def step(state, inp):
        qc, kc, gc, vc = inp
        b = jnp.cumsum(gc, axis=2)
        o_inter = jnp.einsum('bhtk,bhkv->bhtv', qc * jnp.exp(b), state)
        rel = b[:, :, :, None, :] - b[:, :, None, :, :]
        decay = jnp.exp(jnp.where(causal, rel, -jnp.inf))
        scores = jnp.einsum('bhtsk,bhsk->bhts', qc[:, :, :, None, :] * decay, kc)
        o_intra = jnp.einsum('bhts,bhsv->bhtv', scores, vc)
        b_end = b[:, :, -1:, :]
        state = jnp.exp(b_end[:, :, 0, :])[..., None] * state + jnp.einsum('bhsk,bhsv->bhkv', kc * jnp.exp(b_end - b), vc)
        return state, o_inter + o_intra

    state0 = jnp.zeros((B, HG_HEADS, HG_KEY_DIM, HG_VAL_DIM), f32)
    _, o = lax.scan(step, state0, xs)
    o = o.transpose(1, 0, 3, 2, 4).reshape(B, S, HG_HEADS, HG_VAL_DIM)
    o = rms_norm(o, g_norm) * jax.nn.silu(g.astype(f32)).reshape(B, S, HG_HEADS, HG_VAL_DIM)
    return o.reshape(B, S, HG_V).astype(i.dtype)


def fox_mixer(q, k, v, f_logit, f_bias):
    B, S, _ = q.shape
    n_blocks = S // FOX_BLOCK
    f32 = jnp.float32
    q = q.reshape(B, S, FOX_HEADS, FOX_HEAD_DIM) * FOX_HEAD_DIM ** -0.5
    k = k.reshape(B, S, FOX_HEADS, FOX_HEAD_DIM)
    v = v.reshape(B, S, FOX_HEADS, FOX_HEAD_DIM)
    log_f = jax.nn.log_sigmoid(f_logit.astype(f32) + f_bias.astype(f32))
    c = jnp.cumsum(log_f, axis=1).transpose(0, 2, 1)
    q_blocks = q.reshape(B, n_blocks, FOX_BLOCK, FOX_HEADS, FOX_HEAD_DIM).transpose(1, 0, 2, 3, 4)
    c_blocks = c.reshape(B, FOX_HEADS, n_blocks, FOX_BLOCK).transpose(2, 0, 1, 3)
    key_pos = jnp.arange(S)

    def attend(args):
        blk, qb, cb = args
        logits = jnp.einsum('bqhd,bshd->bhqs', qb, k).astype(f32)
        logits = logits + (cb[..., None] - c[:, :, None, :])
        q_pos = blk * FOX_BLOCK + jnp.arange(FOX_BLOCK)
        mask = key_pos[None, :] <= q_pos[:, None]
        p = jax.nn.softmax(jnp.where(mask, logits, -jnp.inf), axis=-1)
        return jnp.einsum('bhqs,bshd->bqhd', p.astype(v.dtype), v)

    o = lax.map(attend, (jnp.arange(n_blocks), q_blocks, c_blocks))
    return o.transpose(1, 0, 2, 3, 4).reshape(B, S, FOX_W)


def conv_glu_ffn(x, w_up, conv_w, conv_b, w_down):
    S = x.shape[1]
    u = x @ w_up
    u_pad = jnp.pad(u, ((0, 0), (CONV_WIDTH - 1, 0), (0, 0)))
    acc = conv_b
    for j in range(CONV_WIDTH):
        acc = acc + conv_w[j] * u_pad[:, j:j + S]
    gate, val = jnp.split(acc, 2, axis=-1)
    return (jax.nn.gelu(gate, approximate=False) * val) @ w_down


def setup_inputs(seed: int = 0) -> dict:
    key = jax.random.key(seed)
    ks = jax.random.split(key, 16)
    f32 = jnp.float32

    def dense(k, shape, fan_in):
        return jax.random.normal(k, shape, f32) * fan_in ** -0.5

    def gain(k, shape):
        return 1.0 + 0.02 * jax.random.normal(k, shape, f32)

    return {
        'x': jax.random.normal(ks[0], (BATCH, SEQ, D_MODEL), f32),
        'norm_mix': gain(ks[1], (DEPTH, D_MODEL)),
        'w_in': dense(ks[2], (DEPTH, D_MODEL, D_IN), D_MODEL),
        'fox_f_bias': FOX_F_BIAS_INIT + 0.5 * jax.random.normal(ks[3], (DEPTH, FOX_HEADS), f32),
        'hg_lb_logits': 0.1 * jax.random.normal(ks[4], (DEPTH + 1, HG_QK), f32),
        'hg_norm': gain(ks[5], (DEPTH, HG_VAL_DIM)),
        'w_branch_a': dense(ks[6], (DEPTH, HG_V, D_MODEL), HG_V),
        'w_branch_b': dense(ks[7], (DEPTH, FOX_W, D_MODEL), FOX_W),
        'w_out': dense(ks[8], (DEPTH, D_MODEL, D_MODEL), D_MODEL),
        'norm_ffn': gain(ks[9], (DEPTH, D_MODEL)),
        'w_up': dense(ks[10], (DEPTH, D_MODEL, 2 * D_FF), D_MODEL),
        'conv_w': dense(ks[11], (DEPTH, CONV_WIDTH, 2 * D_FF), CONV_WIDTH),
        'conv_b': 0.02 * jax.random.normal(ks[12], (DEPTH, 2 * D_FF), f32),
        'w_down': dense(ks[13], (DEPTH, D_FF, D_MODEL), D_FF),
        'norm_final': gain(ks[14], (D_MODEL,)),
    }


def reference(x, norm_mix, w_in, fox_f_bias, hg_lb_logits, hg_norm, w_branch_a, w_branch_b, w_out, norm_ffn, w_up, conv_w, conv_b, w_down, norm_final):
    h = x
    lb_all = jnp.cumsum(jax.nn.softmax(hg_lb_logits.astype(jnp.float32), axis=0), axis=0)
    cuts = np.cumsum(SPLITS)[:-1].tolist()
    for layer in range(DEPTH):
        n = rms_norm(h, norm_mix[layer])
        proj = n @ w_in[layer]
        hq, hf, hi, hg, fq, fk, fv, ff, ga, gb = jnp.split(proj, cuts, axis=-1)
        o_a = hgrn2_mixer(hq, hf, hi, hg, lb_all[layer], hg_norm[layer])
        o_b = fox_mixer(fq, fk, fv, ff, fox_f_bias[layer])
        merged = jax.nn.sigmoid(ga) * (o_a @ w_branch_a[layer]) + jax.nn.sigmoid(gb) * (o_b @ w_branch_b[layer])
        h = h + merged @ w_out[layer]
        h = h + conv_glu_ffn(rms_norm(h, norm_ffn[layer]), w_up[layer], conv_w[layer], conv_b[layer], w_down[layer])
    return rms_norm(h, norm_final)
```

```cpp
#include <hip/hip_runtime.h>
#include <hip/hip_cooperative_groups.h>
#include <hip/hip_runtime.h>
#include <cstdio>
#include <cstdint>
namespace pg8 {
#define PG8_LAS __attribute__((address_space(3)))
typedef unsigned short bf16_t;
typedef short bf16x8 __attribute__((ext_vector_type(8)));
typedef float f32x4 __attribute__((ext_vector_type(4)));
typedef unsigned u32x4 __attribute__((ext_vector_type(4)));
constexpr int BM = 256, BK = 64, HALF = 128, HTB = HALF * BK * 2  , STAGE_BYTES = 8 * HTB, NXCD = 8, WGM = 8;

__host__ __device__ __forceinline__ int lds_byte(int r, int c) { const int st = (r >> 4) * 2 + (c >> 5), rr = r & 15, cc = c & 31, ob = rr * 64 + cc * 2; return st * 1024 + (ob ^ (((ob >> 9) & 1) << 5)); }
__host__ __device__ __forceinline__ void stage_rc(int b, int& R, int& C) { const int st = b / 1024, sb = b % 1024, swz = sb ^ (((sb >> 9) & 1) << 5); R = (st >> 1) * 16 + swz / 64; C = (st & 1) * 32 + (swz % 64) / 2; }
__host__ __device__ __forceinline__ int perm32(int rho) { const int n = rho >> 4, i = rho & 15; return 8 * (i >> 2) + 4 * n + (i & 3); }

struct Unit { int pm, pn; };
struct Gemm { const bf16_t* A; const bf16_t* Bt; int M, N, K; size_t a_tstep; };

struct StaticOrder {
    int nM, nN, nwg, G, c;
    __host__ __device__ void init(int M, int N, int G_, int c_) { nM = M / BM; nN = N / BM; nwg = nM * nN; G = G_; c = c_; }
    __host__ __device__ bool next(int i, Unit& u) const {
        const long L = (long)i * G + c; if (L >= nwg) return false;
        int wgid = (int)L; { const int q = nwg / NXCD, r = nwg % NXCD, xcd = wgid % NXCD, off = wgid / NXCD; wgid = (xcd < r ? xcd * (q + 1) : r * (q + 1) + (xcd - r) * q) + off; }
        const int nig = WGM * nN, gid = wgid / nig, fm = gid * WGM, gsz = (nM - fm) < WGM ? (nM - fm) : WGM;
        u.pm = fm + ((wgid % nig) % gsz); u.pn = (wgid % nig) / gsz; return true;
    }
    __device__ __forceinline__ void a_ready(const Unit&) const {}
    __device__ __forceinline__ void done(const Unit&) const {}
};

__device__ __forceinline__ unsigned cvt_pk_bf16(float lo, float hi) { unsigned r; asm volatile("v_cvt_pk_bf16_f32 %0, %1, %2" : "=v"(r) : "v"(lo), "v"(hi)); return r; }
typedef float f32x2 __attribute__((ext_vector_type(2)));
__device__ __forceinline__ f32x2 gelu_pk(f32x2 v) {
    const f32x2 av = __builtin_elementwise_abs(v), d = av * 0.2316418882f + 1.0f;
    f32x2 t; t.x = __builtin_amdgcn_rcpf(d.x); t.y = __builtin_amdgcn_rcpf(d.y);
    f32x2 q = t * 0.5307027145f + (-0.7265760135f); q = q * t + 0.7107068705f; q = q * t + (-0.142248368f); q = q * t + 0.127414796f; q = q * t;
    const f32x2 s = (v * v) * (-0.72134752044f);
    f32x2 e; e.x = __builtin_amdgcn_exp2f(s.x); e.y = __builtin_amdgcn_exp2f(s.y);
    const f32x2 m = v * (q * e), r = v - m;
    f32x2 o; o.x = v.x < 0.f ? m.x : r.x; o.y = v.y < 0.f ? m.y : r.y; return o;
}

template <class Epi, class Sched, bool ALIGN_EPI = false, bool SP2 = false>
__device__ __forceinline__ void gemm_phase(PG8_LAS unsigned char* lds, const Gemm g, const Sched& S, const Epi& E) {
    const int tid = threadIdx.x, wid = __builtin_amdgcn_readfirstlane(tid >> 6), lane = tid & 63, wr = wid >> 2, wc = wid & 3, fr = lane & 15, fq = lane >> 4;
    const int K = g.K, nt = K / BK;
    unsigned voffA[2], voffB[2];
#pragma unroll
    for (int i = 0; i < 2; ++i) { int R, C; stage_rc(tid * 16 + i * 8192, R, C); const int Rb = Epi::PERM ? ((R & ~31) + perm32(R & 31)) : R;
        voffA[i] = (unsigned)(R * K + C) * 2u; voffB[i] = (unsigned)(Rb * K + C) * 2u; }
    const size_t kstep = (size_t)(BK * 2);
    const size_t hstep = (size_t)HALF * K * 2;
    const size_t tstep = 2 * hstep;
    const unsigned ldsw = (unsigned)wid * 1024u;
    const int aoff = lds_byte(wr * 64 + fr, fq * 8), boff = lds_byte(wc * 32 + fr, fq * 8);
#define PG8_SA(b, h) (((b) * 2 + (h)) * HTB)
#define PG8_SB(b, h) ((4 + (b) * 2 + (h)) * HTB)
#define PG8_STAGE(bufoff, gbase, voff) do { _Pragma("unroll") for (int _i = 0; _i < 2; ++_i) \
        __builtin_amdgcn_global_load_lds((const unsigned*)((const char*)(gbase) + (voff)[_i]), (PG8_LAS unsigned*)(lds + (bufoff) + ldsw + _i * 8192), 16, 0, 0); } while (0)
#define PG8_LDA(dst, b, h) do { _Pragma("unroll") for (int m = 0; m < 4; ++m) _Pragma("unroll") for (int k = 0; k < 2; ++k) dst[m][k] = *(const PG8_LAS bf16x8*)(lds + PG8_SA(b, h) + aoff + m * 2048 + k * 1024); } while (0)
#define PG8_LDB(dst, b, h) do { _Pragma("unroll") for (int n = 0; n < 2; ++n) _Pragma("unroll") for (int k = 0; k < 2; ++k) dst[n][k] = *(const PG8_LAS bf16x8*)(lds + PG8_SB(b, h) + boff + n * 2048 + k * 1024); } while (0)
#define PG8_MMA(ai, bj, At, Bt) do { __builtin_amdgcn_s_setprio(1); _Pragma("unroll") for (int m = 0; m < 4; ++m) _Pragma("unroll") for (int n = 0; n < 2; ++n) _Pragma("unroll") for (int k = 0; k < 2; ++k) \
        acc[ai][bj][m][n] = __builtin_amdgcn_mfma_f32_16x16x32_bf16(Bt[n][k], At[m][k], acc[ai][bj][m][n], 0, 0, 0); __builtin_amdgcn_s_setprio(0); } while (0)
#define PG8_WAIT_V(n) asm volatile("s_waitcnt vmcnt(" #n ")" ::: "memory")
#define PG8_WAIT_L(n) asm volatile("s_waitcnt lgkmcnt(" #n ")" ::: "memory")
#define PG8_BAR __builtin_amdgcn_s_barrier()
#define PG8_SCHED __builtin_amdgcn_sched_barrier(0)
    Unit cur, nxt; int ui = 0;
    if (!S.next(0, cur)) return;
    f32x4 acc[2][2][4][2];
#pragma unroll
    for (int a = 0; a < 2; ++a)
#pragma unroll
        for (int b = 0; b < 2; ++b)
#pragma unroll
            for (int m = 0; m < 4; ++m)
#pragma unroll
                for (int n = 0; n < 2; ++n) acc[a][b][m][n] = (f32x4){0.f, 0.f, 0.f, 0.f};
    bf16x8 At[4][2], B0[2][2], B1[2][2];
    const size_t tstepA = g.a_tstep ? g.a_tstep : tstep; const char* cA = (const char*)g.A + (size_t)cur.pm * tstepA; const char* cB = (const char*)g.Bt + (size_t)cur.pn * tstep;
    S.a_ready(cur);
    if constexpr (SP2) {
        PG8_STAGE(PG8_SB(0, 0), cB, voffB); PG8_STAGE(PG8_SB(0, 1), cB + hstep, voffB); PG8_STAGE(PG8_SA(0, 0), cA, voffA); PG8_STAGE(PG8_SA(0, 1), cA + hstep, voffA);
        if (wr == 1) PG8_BAR;
        PG8_WAIT_V(2); PG8_BAR;
        PG8_STAGE(PG8_SB(1, 0), cB + kstep, voffB); PG8_STAGE(PG8_SA(1, 0), cA + kstep, voffA); PG8_STAGE(PG8_SB(1, 1), cB + hstep + kstep, voffB);
        PG8_WAIT_V(6); PG8_BAR;
    } else {
        PG8_STAGE(PG8_SB(0, 0), cB, voffB); PG8_STAGE(PG8_SA(0, 0), cA, voffA); PG8_STAGE(PG8_SB(0, 1), cB + hstep, voffB); PG8_STAGE(PG8_SA(0, 1), cA + hstep, voffA);
        if (wr == 1) PG8_BAR;
        PG8_WAIT_V(4); PG8_BAR;
        PG8_STAGE(PG8_SB(1, 0), cB + kstep, voffB); PG8_STAGE(PG8_SA(1, 0), cA + kstep, voffA); PG8_STAGE(PG8_SB(1, 1), cB + hstep + kstep, voffB);
        PG8_WAIT_V(6); PG8_BAR;
    }
    for (;;) {
        const bool has_next = S.next(ui + 1, nxt);
        const char* nA = has_next ? (const char*)g.A + (size_t)nxt.pm * tstepA : cA; const char* nB = has_next ? (const char*)g.Bt + (size_t)nxt.pn * tstep : cB;
        for (int t = 0; t < nt; t += 2) {
            const bool last = (t == nt - 2);
            const char* a1 = cA + (size_t)(t + 1) * kstep;
            const char* a2 = last ? nA : cA + (size_t)(t + 2) * kstep; const char* b2 = last ? nB : cB + (size_t)(t + 2) * kstep;
            const char* a3 = a2 + kstep; const char* b3 = b2 + kstep;
            if (last && has_next) S.a_ready(nxt);
            if constexpr (SP2) {
            PG8_LDB(B0, 0, 0); PG8_LDB(B1, 0, 1); PG8_SCHED; PG8_LDA(At, 0, 0); PG8_STAGE(PG8_SA(1, 1), a1 + hstep, voffA);
            PG8_WAIT_V(8); PG8_WAIT_L(0); PG8_BAR; PG8_MMA(0, 0, At, B0); PG8_MMA(0, 1, At, B1); PG8_BAR; PG8_SCHED;
            PG8_LDA(At, 0, 1); PG8_STAGE(PG8_SB(0, 0), b2, voffB); PG8_STAGE(PG8_SB(0, 1), b2 + hstep, voffB); PG8_STAGE(PG8_SA(0, 0), a2, voffA);
            PG8_WAIT_V(8); PG8_WAIT_L(0); PG8_BAR; PG8_MMA(1, 0, At, B0); PG8_MMA(1, 1, At, B1); PG8_BAR; PG8_SCHED;
            PG8_LDB(B0, 1, 0); PG8_LDB(B1, 1, 1); PG8_SCHED; PG8_LDA(At, 1, 0); PG8_STAGE(PG8_SA(0, 1), a2 + hstep, voffA);
            PG8_WAIT_V(8); PG8_WAIT_L(0); PG8_BAR; PG8_MMA(0, 0, At, B0); PG8_MMA(0, 1, At, B1); PG8_BAR; PG8_SCHED;
            PG8_LDA(At, 1, 1); PG8_STAGE(PG8_SB(1, 0), b3, voffB); PG8_STAGE(PG8_SB(1, 1), b3 + hstep, voffB); PG8_STAGE(PG8_SA(1, 0), a3, voffA);
            PG8_WAIT_V(8); PG8_WAIT_L(0); PG8_BAR; PG8_MMA(1, 0, At, B0); PG8_MMA(1, 1, At, B1); PG8_BAR; PG8_SCHED;
            } else {
            PG8_LDB(B0, 0, 0); PG8_SCHED; PG8_LDA(At, 0, 0); PG8_STAGE(PG8_SA(1, 1), a1 + hstep, voffA);
            PG8_WAIT_L(8); PG8_BAR; PG8_WAIT_L(0); PG8_MMA(0, 0, At, B0); PG8_BAR; PG8_SCHED;
            PG8_LDB(B1, 0, 1); PG8_STAGE(PG8_SB(0, 0), b2, voffB);
            PG8_BAR; PG8_WAIT_L(0); PG8_MMA(0, 1, At, B1); PG8_BAR;
            PG8_LDA(At, 0, 1); PG8_STAGE(PG8_SA(0, 0), a2, voffA);
            PG8_BAR; PG8_WAIT_L(0); PG8_MMA(1, 0, At, B0); PG8_BAR; PG8_SCHED;
            PG8_STAGE(PG8_SB(0, 1), b2 + hstep, voffB);
            PG8_WAIT_V(6); PG8_BAR; PG8_MMA(1, 1, At, B1); PG8_BAR;
            PG8_LDB(B0, 1, 0); PG8_SCHED; PG8_LDA(At, 1, 0); PG8_STAGE(PG8_SA(0, 1), a2 + hstep, voffA);
            PG8_WAIT_L(8); PG8_BAR; PG8_WAIT_L(0); PG8_MMA(0, 0, At, B0); PG8_BAR; PG8_SCHED;
            PG8_LDB(B1, 1, 1); PG8_STAGE(PG8_SB(1, 0), b3, voffB);
            PG8_BAR; PG8_WAIT_L(0); PG8_MMA(0, 1, At, B1); PG8_BAR;
            PG8_LDA(At, 1, 1); PG8_STAGE(PG8_SA(1, 0), a3, voffA);
            PG8_BAR; PG8_WAIT_L(0); PG8_MMA(1, 0, At, B0); PG8_BAR; PG8_SCHED;
            PG8_STAGE(PG8_SB(1, 1), b3 + hstep, voffB);
            PG8_WAIT_V(6); PG8_BAR; PG8_MMA(1, 1, At, B1); PG8_BAR;
            }
        }
        if constexpr (ALIGN_EPI) { if (wr == 0) PG8_BAR; }
        if constexpr (!Epi::AFTER_DRAIN) { E(acc, cur, wr, wc, fr, fq); S.done(cur); }
        if (!has_next) break;
#pragma unroll
        for (int a = 0; a < 2; ++a)
#pragma unroll
            for (int b = 0; b < 2; ++b)
#pragma unroll
                for (int m = 0; m < 4; ++m)
#pragma unroll
                    for (int n = 0; n < 2; ++n) acc[a][b][m][n] = (f32x4){0.f, 0.f, 0.f, 0.f};
        cur = nxt; cA = nA; cB = nB; ++ui;
        if constexpr (ALIGN_EPI) { if (wr == 1) PG8_BAR; }
    }
    PG8_WAIT_V(0);
    if constexpr (!ALIGN_EPI) { if (wr == 0) PG8_BAR; }
    PG8_BAR;
    if constexpr (Epi::AFTER_DRAIN) { E.fused(acc, cur, wr, wc, fr, fq, lds, wid, lane); S.done(cur); }
#undef PG8_SA
#undef PG8_SB
#undef PG8_STAGE
#undef PG8_LDA
#undef PG8_LDB
#undef PG8_MMA
#undef PG8_WAIT_V
#undef PG8_WAIT_L
#undef PG8_BAR
#undef PG8_SCHED
}
}

#ifndef PG8_SP2
#define PG8_SP2 true
#endif
#ifndef PG8_ALIGN
#define PG8_ALIGN true
#endif
#include <hip/hip_bf16.h>
#include <cmath>
namespace attn_body {
using bf16=__hip_bfloat16;
using bf16x8=__attribute__((ext_vector_type(8)))short;
using s16x4=__attribute__((ext_vector_type(4)))short;
using f32x16=__attribute__((ext_vector_type(16)))float;
using u32x4=__attribute__((ext_vector_type(4)))unsigned;
constexpr int BATCH=4,NHEAD=16,SEQ=8192,D=64,DM=NHEAD*D;
constexpr int NW=8,QBLK=32,QB=QBLK*NW,KVBLK=64,NQB=SEQ/QB;
constexpr int ATTN_PITCH=DM, ATTN_UNIT_ROWS=QB;
__device__ __forceinline__ int crow(int r,int hi){return (r&3)+8*(r>>2)+4*hi;}
#define SBAR() __builtin_amdgcn_sched_barrier(0)
__device__ __forceinline__ void cmask(f32x16&p0,f32x16&p1,int jb,int qrel,int hi){
  const float NEG=-INFINITY; int kb=64*jb+4*hi;
  #pragma unroll
  for(int r=0;r<16;++r){int kv=kb+(r&3)+8*(r>>2); if(kv>qrel)p0[r]=NEG; if(kv+32>qrel)p1[r]=NEG;}
}

constexpr int NSLOT=3, SLOTB=8192;
constexpr int LDS_K=0, LDS_V=NSLOT*SLOTB, LDS_WS=2*NSLOT*SLOTB, LDS_OST=LDS_WS+NW*64*4, LDS_CB=LDS_OST+NW*4096, LDS_BYTES=LDS_CB+SEQ*8;
constexpr float C2=0.125f*1.4426950408889634f;
__device__ __forceinline__ void glds16(const void*gsrc,unsigned lds_dst){unsigned keep;
  asm volatile("s_mov_b32 %0, m0\n\ts_mov_b32 m0, %2\n\ts_nop 0\n\tglobal_load_lds_dwordx4 %1, off\n\ts_mov_b32 m0, %0":"=&s"(keep):"v"(gsrc),"s"(lds_dst):"memory");}
__device__ __forceinline__ float max3f(float a,float b,float c){float r;asm("v_max3_f32 %0, %1, %2, %3":"=v"(r):"v"(a),"v"(b),"v"(c));return r;}
__device__ __forceinline__ float max2f(float a,float b){float r;asm("v_max_f32_e32 %0, %1, %2":"=v"(r):"v"(a),"v"(b));return r;}
__device__ __forceinline__ float fadd_s(float a,float b){float r;asm("v_add_f32_e32 %0, %1, %2":"=v"(r):"v"(a),"v"(b));return r;}
__device__ __forceinline__ float fsub_s(float a,float b){float r;asm("v_sub_f32_e32 %0, %1, %2":"=v"(r):"v"(a),"v"(b));return r;}
typedef float f32x2_t __attribute__((ext_vector_type(2))); typedef float f32x4_t __attribute__((ext_vector_type(4))); typedef __bf16 bf16x2_t __attribute__((ext_vector_type(2)));
__device__ __forceinline__ unsigned cvtpk_s(float lo,float hi){f32x2_t v={lo,hi};bf16x2_t b=__builtin_convertvector(v,bf16x2_t);return __builtin_bit_cast(unsigned,b);}
#define WAIT_BAR(N) asm volatile("s_waitcnt vmcnt(" #N ") lgkmcnt(0)\n\ts_barrier":::"memory")

__device__ __forceinline__ void qkt(f32x16&p0,f32x16&p1,const char*Kslot,const bf16x8*qr,const f32x16&negm,int r32,int hi){
  const char*kb=Kslot+hi*1024+r32*16;
  #pragma unroll
  for(int d0=0;d0<4;++d0){
    const bf16x8 b0=*reinterpret_cast<const bf16x8*>(kb+d0*2048);
    const bf16x8 b1=*reinterpret_cast<const bf16x8*>(kb+d0*2048+512);
    if(d0==0){p0=__builtin_amdgcn_mfma_f32_32x32x16_bf16(b0,qr[0],negm,0,0,0);p1=__builtin_amdgcn_mfma_f32_32x32x16_bf16(b1,qr[0],negm,0,0,0);}
    else{p0=__builtin_amdgcn_mfma_f32_32x32x16_bf16(b0,qr[d0],p0,0,0,0);p1=__builtin_amdgcn_mfma_f32_32x32x16_bf16(b1,qr[d0],p1,0,0,0);}}
}
typedef __attribute__((address_space(3))) const char* lds_cptr;
typedef short v4i16_t __attribute__((ext_vector_type(4)));
__device__ __forceinline__ void kload8(bf16x8*kf,lds_cptr kp){
  kf[0]=*(const __attribute__((address_space(3))) bf16x8*)(kp);      kf[1]=*(const __attribute__((address_space(3))) bf16x8*)(kp+512);
  kf[2]=*(const __attribute__((address_space(3))) bf16x8*)(kp+2048); kf[3]=*(const __attribute__((address_space(3))) bf16x8*)(kp+2560);
  kf[4]=*(const __attribute__((address_space(3))) bf16x8*)(kp+4096); kf[5]=*(const __attribute__((address_space(3))) bf16x8*)(kp+4608);
  kf[6]=*(const __attribute__((address_space(3))) bf16x8*)(kp+6144); kf[7]=*(const __attribute__((address_space(3))) bf16x8*)(kp+6656);
}
__device__ __forceinline__ void kload2(bf16x8*kf,lds_cptr kp,int j){ kf[2*j]=*(const __attribute__((address_space(3))) bf16x8*)(kp+j*2048); kf[2*j+1]=*(const __attribute__((address_space(3))) bf16x8*)(kp+j*2048+512); }
__device__ __forceinline__ s16x4 vtr(lds_cptr p){ return __builtin_bit_cast(s16x4,__builtin_amdgcn_ds_read_tr16_b64_v4i16((__attribute__((address_space(3))) v4i16_t*)p)); }
__device__ __forceinline__ float rowmax(const f32x16&p0,const f32x16&p1){
  float a=max3f(p0[0],p0[1],p1[0]),b=max3f(p0[2],p0[3],p1[1]);a=max3f(a,p1[2],p1[3]);
  #pragma unroll
  for(int r=4;r<16;r+=4){a=max3f(a,p0[r],p0[r+1]);b=max3f(b,p0[r+2],p0[r+3]);a=max3f(a,p1[r],p1[r+1]);b=max3f(b,p1[r+2],p1[r+3]);}
  const float m=max2f(a,b);
  auto rr=__builtin_amdgcn_permlane32_swap(__float_as_uint(m),__float_as_uint(m),false,false);
  return max2f(__uint_as_float(rr[0]),__uint_as_float(rr[1]));
}
__device__ __forceinline__ void pv(f32x16*o,int vb,bf16x8 pa0,bf16x8 pa1,bf16x8 pa2,bf16x8 pa3){
  #pragma unroll
  for(int d0=0;d0<2;++d0){s16x4 lo[4],hi[4];
    #pragma unroll
    for(int ks=0;ks<4;++ks){
      asm volatile("ds_read_b64_tr_b16 %0,%1 offset:%c2":"=&v"(lo[ks]):"v"(vb),"i"(d0*4096+ks*1024):"memory");
      asm volatile("ds_read_b64_tr_b16 %0,%1 offset:%c2":"=&v"(hi[ks]):"v"(vb),"i"(d0*4096+ks*1024+512):"memory");}
    asm volatile("s_waitcnt lgkmcnt(0)":::"memory");SBAR();
    #define PK(k) (bf16x8){lo[k][0],lo[k][1],lo[k][2],lo[k][3],hi[k][0],hi[k][1],hi[k][2],hi[k][3]}
    o[d0]=__builtin_amdgcn_mfma_f32_32x32x16_bf16(pa0,PK(0),o[d0],0,0,0);
    o[d0]=__builtin_amdgcn_mfma_f32_32x32x16_bf16(pa1,PK(1),o[d0],0,0,0);
    o[d0]=__builtin_amdgcn_mfma_f32_32x32x16_bf16(pa2,PK(2),o[d0],0,0,0);
    o[d0]=__builtin_amdgcn_mfma_f32_32x32x16_bf16(pa3,PK(3),o[d0],0,0,0);
    #undef PK
  }
}

#ifndef ATTN_STORE16
#define ATTN_STORE16(p,v) (*(u32x4*)(p)=(v))
#endif
template<int THRL> __device__ __forceinline__ void attn_unit(int b,int h,int qb,const bf16*Q,const bf16*__restrict__ K,const bf16*__restrict__ V,bf16*O,const float*__restrict__ CLbh,char*shm){
  const int tid=threadIdx.x,lane=tid&63,r32=lane&31,hi=lane>>5; const int wid=__builtin_amdgcn_readfirstlane(tid>>6);
  const long rowbase=(long)b*SEQ; const int q0=qb*QB;
  const bf16*Qw=Q+(rowbase+q0+wid*QBLK)*DM+h*D;
  const bf16*Kh=K+rowbase*DM+h*D,*Vh=V+rowbase*DM+h*D;
  const unsigned lds0=(unsigned)(uintptr_t)shm;
  float*wsf=(float*)(shm+LDS_WS)+wid*64;
  const bf16*ksrc=Kh+(long)lane*DM+wid*8;
  const bf16*vsrc=Vh+(long)(16*(wid&3)+(lane>>2))*DM+(wid>>2)*32+(lane&3)*8;
  const unsigned kdst=lds0+LDS_K+wid*1024, vdst=lds0+LDS_V+wid*1024;
  #define DMA_K(t,slot) glds16(ksrc+(long)(t)*KVBLK*DM,(unsigned)__builtin_amdgcn_readfirstlane(kdst+(slot)))
  #define DMA_V(t,slot) glds16(vsrc+(long)(t)*KVBLK*DM,(unsigned)__builtin_amdgcn_readfirstlane(vdst+(slot)))
  const int vb0=(int)(lds0+LDS_V)+((lane>>4)&1)*32+(lane&3)*8+(4*hi+((lane&15)>>2))*64;
  const char*Kbase=shm+LDS_K; bf16x8 kf[8];
  const lds_cptr shm3=(lds_cptr)shm; const lds_cptr kp0=shm3+LDS_K+hi*1024+r32*16; const lds_cptr vp0=shm3+LDS_V+((lane>>4)&1)*32+(lane&3)*8+(4*hi+((lane&15)>>2))*64;
  const int NT=(q0+QB)/KVBLK;
  { const float cref=CLbh[q0+QB-1]; unsigned long long*cbw=(unsigned long long*)(shm+LDS_CB);
    for(int i_=tid;i_<q0+QB;i_+=NW*64){ const float v_=cref-CLbh[i_]; const unsigned b1_=cvtpk_s(v_,0.f)&0xffffu; const float r1_=v_-__uint_as_float(b1_<<16);
      const unsigned b2_=cvtpk_s(r1_,0.f)&0xffffu; const float r2_=r1_-__uint_as_float(b2_<<16); const unsigned b3_=cvtpk_s(r2_,0.f)&0xffffu;
      cbw[i_]=(unsigned long long)(b1_|(b2_<<16))|((unsigned long long)b3_<<32); }
    asm volatile("s_waitcnt vmcnt(0) lgkmcnt(0)\n\ts_barrier":::"memory"); }
  const lds_cptr cbp0=(lds_cptr)shm+LDS_CB+r32*8;
  const short one_=(hi==0)?(short)0x3f80:(short)0; const bf16x8 ones=(bf16x8){one_,one_,one_,0,0,0,0,0};
  #define BLD(t,k) ({ const s16x4 lo_=*(const __attribute__((address_space(3))) s16x4*)(cbp0+(t)*512+(k)*256); (bf16x8){lo_[0],lo_[1],lo_[2],lo_[3],0,0,0,0}; })
  DMA_K(0,0);DMA_V(0,0);DMA_K(1,SLOTB);
  bf16x8 qr[4];
  #pragma unroll
  for(int d0=0;d0<4;++d0)qr[d0]=*reinterpret_cast<const bf16x8*>(&Qw[(long)r32*DM+d0*16+hi*8]);
  float mhat=0.f,l_reg=0.f;f32x16 o[2];o[0]=f32x16{};o[1]=f32x16{};f32x16 negm=f32x16{};asm volatile("":"+v"(negm));
  const int qrel=wid*QBLK+r32;
  #define CMASK(P0,P1,t) do{int jb_=(t)-(NT-4); if(jb_>=0)cmask(P0,P1,jb_,qrel,hi);}while(0)
  bool resc=false;
  #define START(P0,P1) do{ const float rm=rowmax(P0,P1); resc=false; \
    { const float dl=rm; mhat=fadd_s(mhat,dl); \
      _Pragma("unroll") for(int r=0;r<16;++r){P0[r]=fsub_s(P0[r],dl);P1[r]=fsub_s(P1[r],dl);} \
      _Pragma("unroll") for(int r=0;r<16;++r)negm[r]=-mhat; asm volatile("":"+v"(negm)); } \
    _Pragma("unroll") for(int r=0;r<16;++r)P0[r]=__builtin_amdgcn_exp2f(P0[r]); }while(0)
  #define RESC() do{ if(resc){ asm volatile("s_waitcnt lgkmcnt(0)":::"memory"); \
      _Pragma("unroll") for(int d_=0;d_<2;++d_) _Pragma("unroll") for(int r=0;r<16;++r)o[d_][r]*=wsf[crow(r,hi)]; } }while(0)
  f32x16 pA0,pA1,pB0,pB1;
  int sl_prev=0,sl_cur=0,sl_next=SLOTB;
  #define ROT() do{sl_prev=sl_cur;sl_cur=sl_next;sl_next=(sl_next==(NSLOT-1)*SLOTB)?0:sl_next+SLOTB;}while(0)
  DMA_K(2,2*SLOTB);
  WAIT_BAR(3);
  qkt(pA0,pA1,Kbase,qr,negm,r32,hi);{const bf16x8 ba0_=BLD(0,0),ba1_=BLD(0,1);pA0=__builtin_amdgcn_mfma_f32_32x32x16_bf16(ba0_,ones,pA0,0,0,0);pA1=__builtin_amdgcn_mfma_f32_32x32x16_bf16(ba1_,ones,pA1,0,0,0);}asm volatile("s_nop 15\n\ts_nop 7":"+v"(pA0),"+v"(pA1));CMASK(pA0,pA1,0);
  START(pA0,pA1);
  _Pragma("unroll") for(int r=0;r<16;++r)pA1[r]=__builtin_amdgcn_exp2f(pA1[r]);
  WAIT_BAR(0);
  DMA_K(3,0);DMA_V(1,SLOTB);
  ROT();
  kload8(kf,kp0+sl_cur);
  WAIT_BAR(2);
  s16x4 vlo[8],vhi[8]; u32x4 pw0,pw1,pw2,pw3;
  #define PKW(P,B) cvtpk_s(P[B],P[B+1])
  #define PAF(k) __builtin_bit_cast(bf16x8,pw##k)
  #define VFR(i) (bf16x8){vlo[i][0],vlo[i][1],vlo[i][2],vlo[i][3],vhi[i][0],vhi[i][1],vhi[i][2],vhi[i][3]}
  #define PIN(x) asm volatile("":"+v"(x))
  #define MX3(a,b,c) __builtin_fmaxf(__builtin_fmaxf((a),(b)),(c))
  #define GAPA(MF,A0,A1,A2,A3,W0,W1,PW) do{ MF; sacc+=A0; sacc+=A1; sacc+=A2; sacc+=A3; PIN(sacc); W0; W1; PIN(PW); SBAR(); }while(0)
  #define EX(v) __builtin_amdgcn_exp2f(v)
  #define GAPB(MF,X,B) do{ MF; X[B]=EX(X[B]); X[B+1]=EX(X[B+1]); X[B+2]=EX(X[B+2]); X[B+3]=EX(X[B+3]); PIN(X); SBAR(); }while(0)
  #define VRD(i) do{ vlo[i]=vtr(vp_+(((i)>>2)*4096+((i)&3)*1024)); vhi[i]=vtr(vp_+(((i)>>2)*4096+((i)&3)*1024+512)); }while(0)
  #define KRD(G,j) do{ if(G){ kload2(kf,kp0+sl_next,j); SBAR(); } }while(0)
  #define STEP(C0,C1,P0,P1,t,GK,GV,GL) do{ SBAR(); \
    const lds_cptr vp_=vp0+sl_prev; const bf16x8 ba0_=BLD(t,0),ba1_=BLD(t,1); \
    VRD(0); SBAR(); float sacc=(P0[0]+P0[1]); \
    GAPA(C0=__builtin_amdgcn_mfma_f32_32x32x16_bf16(kf[0],qr[0],negm,0,0,0), P0[2],P0[3],P0[4],P0[5],     pw0[0]=PKW(P0,0), pw0[1]=PKW(P0,2), pw0); \
    VRD(4); SBAR(); GAPA(C1=__builtin_amdgcn_mfma_f32_32x32x16_bf16(kf[1],qr[0],negm,0,0,0), P0[6],P0[7],P0[8],P0[9],     pw0[2]=PKW(P0,4), pw0[3]=PKW(P0,6), pw0); \
    VRD(1); SBAR(); GAPA(C0=__builtin_amdgcn_mfma_f32_32x32x16_bf16(kf[2],qr[1],C0,0,0,0),   P0[10],P0[11],P0[12],P0[13], pw1[0]=PKW(P0,8), pw1[1]=PKW(P0,10), pw1); \
    VRD(5); SBAR(); GAPA(C1=__builtin_amdgcn_mfma_f32_32x32x16_bf16(kf[3],qr[1],C1,0,0,0),   P0[14],P0[15],P1[0],P1[1],   pw1[2]=PKW(P0,12),pw1[3]=PKW(P0,14), pw1); \
    VRD(2); SBAR(); GAPA(C0=__builtin_amdgcn_mfma_f32_32x32x16_bf16(kf[4],qr[2],C0,0,0,0),   P1[2],P1[3],P1[4],P1[5],     pw2[0]=PKW(P1,0), pw2[1]=PKW(P1,2), pw2); \
    VRD(6); SBAR(); GAPA(C1=__builtin_amdgcn_mfma_f32_32x32x16_bf16(kf[5],qr[2],C1,0,0,0),   P1[6],P1[7],P1[8],P1[9],     pw2[2]=PKW(P1,4), pw2[3]=PKW(P1,6), pw2); \
    VRD(3); SBAR(); GAPA(C0=__builtin_amdgcn_mfma_f32_32x32x16_bf16(kf[6],qr[3],C0,0,0,0),   P1[10],P1[11],P1[12],P1[13], pw3[0]=PKW(P1,8), pw3[1]=PKW(P1,10), pw3); \
    VRD(7); SBAR(); GAPA(C1=__builtin_amdgcn_mfma_f32_32x32x16_bf16(kf[7],qr[3],C1,0,0,0),   P1[14],P1[15],0.f,0.f,       pw3[2]=PKW(P1,12),pw3[3]=PKW(P1,14), pw3); \
    C0=__builtin_amdgcn_mfma_f32_32x32x16_bf16(ba0_,ones,C0,0,0,0); C1=__builtin_amdgcn_mfma_f32_32x32x16_bf16(ba1_,ones,C1,0,0,0); SBAR(); \
    l_reg+=sacc; \
    if(GK){DMA_K((t)+3,sl_cur);} if(GV){DMA_V((t)+1,sl_next);} \
    CMASK(C0,C1,t); \
    { float a=MX3(C0[0],C0[1],C1[0]),b=MX3(C0[2],C0[3],C1[1]); a=MX3(a,C1[2],C1[3]); \
      _Pragma("unroll") for(int r=4;r<16;r+=4){a=MX3(a,C0[r],C0[r+1]);b=MX3(b,C0[r+2],C0[r+3]);a=MX3(a,C1[r],C1[r+1]);b=MX3(b,C1[r+2],C1[r+3]);} \
      float rm=__builtin_fmaxf(a,b); { auto rr=__builtin_amdgcn_permlane32_swap(__float_as_uint(rm),__float_as_uint(rm),false,false); rm=__builtin_fmaxf(__uint_as_float(rr[0]),__uint_as_float(rr[1])); } \
      resc=false; \
      if(__builtin_expect(__any(rm>(float)THRL),0)){ const float dl=__builtin_fmaxf(rm,0.f); mhat+=dl; \
        _Pragma("unroll") for(int r=0;r<16;++r){C0[r]-=dl;C1[r]-=dl;} \
        _Pragma("unroll") for(int r=0;r<16;++r)negm[r]=-mhat; asm volatile("":"+v"(negm)); \
        const float f=__builtin_amdgcn_exp2f(-dl); l_reg*=f; if(hi==0)wsf[r32]=f; resc=true; } } \
    SBAR(); \
    GAPB(o[0]=__builtin_amdgcn_mfma_f32_32x32x16_bf16(PAF(0),VFR(0),o[0],0,0,0), C0,0); \
    GAPB(o[1]=__builtin_amdgcn_mfma_f32_32x32x16_bf16(PAF(0),VFR(4),o[1],0,0,0), C0,4); \
    KRD(GL,0); GAPB(o[0]=__builtin_amdgcn_mfma_f32_32x32x16_bf16(PAF(1),VFR(1),o[0],0,0,0), C0,8); \
    KRD(GL,1); GAPB(o[1]=__builtin_amdgcn_mfma_f32_32x32x16_bf16(PAF(1),VFR(5),o[1],0,0,0), C0,12); \
    KRD(GL,2); GAPB(o[0]=__builtin_amdgcn_mfma_f32_32x32x16_bf16(PAF(2),VFR(2),o[0],0,0,0), C1,0); \
    KRD(GL,3); GAPB(o[1]=__builtin_amdgcn_mfma_f32_32x32x16_bf16(PAF(2),VFR(6),o[1],0,0,0), C1,4); \
    GAPB(o[0]=__builtin_amdgcn_mfma_f32_32x32x16_bf16(PAF(3),VFR(3),o[0],0,0,0), C1,8); \
    GAPB(o[1]=__builtin_amdgcn_mfma_f32_32x32x16_bf16(PAF(3),VFR(7),o[1],0,0,0), C1,12); \
    }while(0)
  int t=1;
  #undef CMASK
  #define CMASK(P0,P1,t) do{}while(0)
  for(;t+5<NT;t+=2){
    STEP(pB0,pB1,pA0,pA1,t,true,true,true);     WAIT_BAR(2); RESC(); ROT();
    STEP(pA0,pA1,pB0,pB1,t+1,true,true,true);   WAIT_BAR(2); RESC(); ROT();
  }
  #undef CMASK
  #define CMASK(P0,P1,t) do{int jb_=(t)-(NT-4); if(jb_>=0)cmask(P0,P1,jb_,qrel,hi);}while(0)
  #define ENDW(tt) do{ if((tt)+3<NT){WAIT_BAR(2);} else if((tt)+2<NT){WAIT_BAR(1);} else {WAIT_BAR(0);} }while(0)
  for(;t+1<NT;t+=2){
    STEP(pB0,pB1,pA0,pA1,t,(t+3<NT),(t+1<NT),(t+1<NT));       ENDW(t);   RESC(); ROT();
    STEP(pA0,pA1,pB0,pB1,t+1,(t+4<NT),(t+2<NT),(t+2<NT));     ENDW(t+1); RESC(); ROT();
  }
  STEP(pB0,pB1,pA0,pA1,NT-1,false,false,false); RESC();
  { float sacc=pB0[0]+pB0[1]; _Pragma("unroll") for(int r=2;r<16;++r)sacc+=pB0[r]; _Pragma("unroll") for(int r=0;r<16;++r)sacc+=pB1[r]; l_reg+=sacc;
    pw0=(u32x4){PKW(pB0,0),PKW(pB0,2),PKW(pB0,4),PKW(pB0,6)};pw1=(u32x4){PKW(pB0,8),PKW(pB0,10),PKW(pB0,12),PKW(pB0,14)};pw2=(u32x4){PKW(pB1,0),PKW(pB1,2),PKW(pB1,4),PKW(pB1,6)};pw3=(u32x4){PKW(pB1,8),PKW(pB1,10),PKW(pB1,12),PKW(pB1,14)};
    SBAR(); pv(o,vb0+sl_cur,PAF(0),PAF(1),PAF(2),PAF(3)); }
  #undef PKW
  #undef PAF
  #undef VFR
  #undef PIN
  #undef MX3
  #undef GAPA
  #undef GAPB
  #undef EX
  #undef VRD
  #undef KRD
  #undef STEP
  #undef ENDW
  {auto rr=__builtin_amdgcn_permlane32_swap(__float_as_uint(l_reg),__float_as_uint(l_reg),false,false);l_reg=__uint_as_float(rr[0])+__uint_as_float(rr[1]);}
  if(hi==0)wsf[32+r32]=l_reg;asm volatile("s_waitcnt lgkmcnt(0)":::"memory");
  float rli[16];
  #pragma unroll
  for(int r=0;r<16;++r)rli[r]=__builtin_amdgcn_rcpf(wsf[32+crow(r,hi)]);
  bf16*Ow=O+(rowbase+q0+wid*QBLK)*DM+h*D;
  { bf16*stg=(bf16*)(shm+LDS_OST)+wid*2048;
    #pragma unroll
    for(int r=0;r<16;++r){const int orow=crow(r,hi);
      #pragma unroll
      for(int d0=0;d0<2;++d0)stg[orow*64+d0*32+r32]=__float2bfloat16(o[d0][r]*rli[r]);}
    asm volatile("s_waitcnt lgkmcnt(0)":::"memory");
    #pragma unroll
    for(int i=0;i<4;++i){const int row=i*8+(lane>>3),ch=lane&7; const u32x4 v=*(const u32x4*)(stg+row*64+ch*8); ATTN_STORE16(Ow+(long)row*DM+ch*8,v);} }
  asm volatile("s_waitcnt lgkmcnt(0)\n\ts_barrier":::"memory");
  #undef DMA_K
  #undef BLD
  #undef DMA_V
  #undef CMASK
  #undef START
  #undef RESC
  #undef ROT
}
constexpr int ATTN_LDS_BYTES=LDS_BYTES;
struct AttnTensors { const bf16* Q; const bf16* K; const bf16* V; bf16* O; const float* CL; };
struct AttnUnit { int bh; int qb; };
struct StaticOrder {
  int vcu;
  __device__ __forceinline__ explicit StaticOrder(int grid,int block):vcu((block%8)*(grid/8)+block/8){}
  __device__ __forceinline__ bool next(int i,AttnUnit&u)const{ if(i>=8)return false; const int s=vcu&7,j=i&3; u.bh=(vcu>>3)+32*(i>>2); u.qb=(j==0)?s:(j==1)?15-s:(j==2)?16+s:31-s; return true; }
  __device__ __forceinline__ void a_ready(const AttnUnit&)const{}
  __device__ __forceinline__ void done(const AttnUnit&)const{}
};
template<class Sched,int THRL=8> __device__ __forceinline__ void attn_phase(char*lds,const AttnTensors&T,const Sched&S){
  AttnUnit u;
  for(int i=0;S.next(i,u);++i){ S.a_ready(u); attn_unit<THRL>(u.bh/NHEAD,u.bh%NHEAD,u.qb,T.Q,T.K,T.V,T.O,T.CL+(long)u.bh*SEQ,lds); S.done(u); }
}
#undef SBAR
#undef WAIT_BAR
}
namespace cg = cooperative_groups;
#define LAS __attribute__((address_space(3)))
typedef unsigned short bf16;
typedef unsigned v4u __attribute__((ext_vector_type(4)));
typedef unsigned v2u __attribute__((ext_vector_type(2)));
typedef float f32x4 __attribute__((ext_vector_type(4)));
typedef float f32x16 __attribute__((ext_vector_type(16)));
typedef short bf16x8 __attribute__((ext_vector_type(8)));
typedef short s16x4 __attribute__((ext_vector_type(4)));

constexpr int NWAVES = 8, NTHR = 512;
constexpr int BATCH = 4, SEQ = 8192, D = 1024, M = BATCH * SEQ;
constexpr int DIN = 9232, DFF = 2816, NUP = 2 * DFF;
constexpr float EPS = 1e-6f, LOG2E = 1.4426950408889634f;
constexpr size_t MiB = 1u << 20;
constexpr size_t WS_SS1 = 0, WS_SS2 = 128 * 1024, WS_LBV = 256 * 1024;
constexpr size_t WS_FLOG = 1 * MiB, WS_CL = 3 * MiB, WS_DK = 5 * MiB;
constexpr size_t WS_WIN = 8 * MiB, WS_WA = 26 * MiB, WS_WB = 28 * MiB, WS_WO = 30 * MiB, WS_WUP = 32 * MiB, WS_WDN = 43 * MiB;
constexpr size_t WS_SLOT0 = 52 * MiB, SLOT = 64 * MiB;
constexpr size_t WS_END = WS_SLOT0 + 7 * SLOT;
constexpr int RING_BYTES = 131072, HALO_OFF = RING_BYTES, MISC_OFF = RING_BYTES + 8192, LDS_BYTES = 151552;
constexpr int UP_TM = 254, UP_NM = 130;
static_assert(attn_body::ATTN_LDS_BYTES <= LDS_BYTES, "attention LDS");

#define LDS_WAIT() asm volatile("s_waitcnt lgkmcnt(0)" ::: "memory")
__device__ __forceinline__ unsigned f2bf(float f) { unsigned u = __builtin_bit_cast(unsigned, f); return (u + 0x7fffu + ((u >> 16) & 1u)) >> 16; }
__device__ __forceinline__ unsigned pk2(float lo, float hi) { return pg8::cvt_pk_bf16(lo, hi); }
__device__ __forceinline__ float bf2f(unsigned short v) { return __builtin_bit_cast(float, (unsigned)v << 16); }
__device__ __forceinline__ float bflo(unsigned w) { return __builtin_bit_cast(float, w << 16); }
__device__ __forceinline__ float bfhi(unsigned w) { return __builtin_bit_cast(float, w & 0xffff0000u); }
__device__ __forceinline__ float wave_sum(float v) {
#pragma unroll
    for (int o = 1; o < 64; o <<= 1) v += __shfl_xor(v, o);
    return v;
}
__device__ __forceinline__ float fexp(float x) { return __builtin_amdgcn_exp2f(x * LOG2E); }
__device__ __forceinline__ float flog(float x) { return __builtin_amdgcn_logf(x) * 0.6931471805599453f; }
__device__ __forceinline__ float fsigmoid(float x) { return __builtin_amdgcn_rcpf(1.0f + fexp(-x)); }
__device__ __forceinline__ int crow(int r, int hi) { return (r & 3) + 8 * (r >> 2) + 4 * hi; }

__device__ __forceinline__ void transpose_item(const float* W, int ldw, bf16* WT, int Kd, int k0, int n0, int dst_row0, LAS float* scr, int lane) {
#pragma unroll 8
    for (int i = 0; i < 32; ++i) { const int kk = 2 * i + (lane >> 5); scr[kk * 33 + (lane & 31)] = W[(size_t)(k0 + kk) * ldw + n0 + (lane & 31)]; }
    LDS_WAIT(); asm volatile("" ::: "memory");
    const int c = lane & 7;
#pragma unroll
    for (int j = 0; j < 4; ++j) { const int n = (lane >> 3) + 8 * j; const LAS float* s = scr + (8 * c) * 33 + n;
        v4u o; o.x = pk2(s[0 * 33], s[1 * 33]); o.y = pk2(s[2 * 33], s[3 * 33]); o.z = pk2(s[4 * 33], s[5 * 33]); o.w = pk2(s[6 * 33], s[7 * 33]);
        *(v4u*)(WT + (size_t)(dst_row0 + n) * Kd + k0 + 8 * c) = o; }
    LDS_WAIT(); asm volatile("" ::: "memory");
}

struct Ptrs {
    const float *x, *norm_mix, *w_in, *fbias, *lblog, *hg_norm, *w_a, *w_b, *w_o, *norm_ffn, *w_up, *conv_w, *conv_b, *w_dn, *norm_final;
    float* out; unsigned char* ws;
};

__device__ __forceinline__ void p0_prologue(LAS unsigned char* lds, const Ptrs& P, int G) {
    const int tid = threadIdx.x, lane = tid & 63, wave = tid >> 6;
    const int gw = blockIdx.x * NWAVES + wave, NGW = G * NWAVES;
    unsigned char* ws = P.ws;
    bf16* Wt_in = (bf16*)(ws + WS_WIN);
    {
        LAS float* scr = (LAS float*)(lds + wave * 16384);
        constexpr int I0 = 16 * 224, I1 = 16 * 64, I2 = 16 * 32, I5 = 16 * 176, I6 = 44 * 32;
        constexpr int NIT = I0 + I1 + 3 * I2 + I5 + I6;
        for (int it = gw; it < NIT; it += NGW) {
            int r = it;
            if (r < I0) { const int kb = r / 224, nb = r % 224; transpose_item(P.w_in, DIN, Wt_in, D, 64 * kb, 32 * nb, 32 * nb, scr, lane); continue; } r -= I0;
            if (r < I1) { const int kb = r / 64, nb = r % 64; transpose_item(P.w_in + 7184, DIN, Wt_in, D, 64 * kb, 32 * nb, 7168 + 32 * nb, scr, lane); continue; } r -= I1;
            if (r < I2) { const int kb = r / 32, nb = r % 32; transpose_item(P.w_a, D, (bf16*)(ws + WS_WA), D, 64 * kb, 32 * nb, 32 * nb, scr, lane); continue; } r -= I2;
            if (r < I2) { const int kb = r / 32, nb = r % 32; transpose_item(P.w_b, D, (bf16*)(ws + WS_WB), D, 64 * kb, 32 * nb, 32 * nb, scr, lane); continue; } r -= I2;
            if (r < I2) { const int kb = r / 32, nb = r % 32; transpose_item(P.w_o, D, (bf16*)(ws + WS_WO), D, 64 * kb, 32 * nb, 32 * nb, scr, lane); continue; } r -= I2;
            if (r < I5) { const int kb = r / 176, nb = r % 176; const int n0 = 32 * nb; const int nn = n0 < DFF ? n0 : n0 - DFF;
                const int dst = 256 * (nn / 128) + (nn % 128) + (n0 < DFF ? 0 : 128);
                transpose_item(P.w_up, NUP, (bf16*)(ws + WS_WUP), D, 64 * kb, n0, dst, scr, lane); continue; } r -= I5;
            { const int kb = r / 32, nb = r % 32; transpose_item(P.w_dn, D, (bf16*)(ws + WS_WDN), DFF, 64 * kb, 32 * nb, 32 * nb, scr, lane); }
        }
    }
    { float* ss = (float*)(ws + WS_SS1); for (int i = blockIdx.x * NTHR + tid; i < 2 * M; i += G * NTHR) ss[i] = 0.f; }
    if (blockIdx.x == 0) { float* lbv = (float*)(ws + WS_LBV); for (int k = tid; k < 1024; k += NTHR) lbv[k] = fsigmoid(P.lblog[k] - P.lblog[1024 + k]); }
    __syncthreads();
    LAS float* wf = (LAS float*)lds;
    for (int i = tid; i < 1024 * 16; i += NTHR) wf[i] = P.w_in[(size_t)(i >> 4) * DIN + 7168 + (i & 15)];
    __syncthreads();
    f32x4 gm[4];
#pragma unroll
    for (int j = 0; j < 4; ++j) gm[j] = ((const f32x4*)P.norm_mix)[lane + 64 * j];
    const float fb = P.fbias[(lane >> 2) & 15];
    bf16* XN = (bf16*)(ws + WS_SLOT0);
    float* FLOG = (float*)(ws + WS_FLOG);
    for (int m = gw; m < M; m += NGW) {
        const f32x4* xr = (const f32x4*)(P.x + (size_t)m * D) + lane;
        f32x4 v[4]; float s2 = 0.f;
#pragma unroll
        for (int j = 0; j < 4; ++j) { v[j] = xr[64 * j]; s2 += (v[j].x * v[j].x + v[j].y * v[j].y) + (v[j].z * v[j].z + v[j].w * v[j].w); }
        const float rstd = 1.0f / sqrtf(wave_sum(s2) * (1.f / D) + EPS);
        unsigned long long* o8 = (unsigned long long*)(XN + (size_t)m * D) + lane;
        float acc[16];
#pragma unroll
        for (int i = 0; i < 16; ++i) acc[i] = 0.f;
#pragma unroll
        for (int j = 0; j < 4; ++j) {
            v[j] = v[j] * rstd * gm[j];
            o8[64 * j] = (unsigned long long)pk2(v[j].x, v[j].y) | ((unsigned long long)pk2(v[j].z, v[j].w) << 32);
#pragma unroll
            for (int e = 0; e < 4; ++e) { const LAS f32x4* wr = (const LAS f32x4*)(wf + (256 * j + 4 * lane + e) * 16); const float xv = v[j][e];
#pragma unroll
                for (int q = 0; q < 4; ++q) { const f32x4 w = wr[q]; acc[4 * q] += xv * w.x; acc[4 * q + 1] += xv * w.y; acc[4 * q + 2] += xv * w.z; acc[4 * q + 3] += xv * w.w; } }
        }
        float a8[8], a4[4], a2[2], a1;
        { const bool up = lane & 32;
#pragma unroll
          for (int i = 0; i < 8; ++i) { const float mine = up ? acc[i + 8] : acc[i], oth = up ? acc[i] : acc[i + 8]; a8[i] = mine + __shfl_xor(oth, 32); } }
        { const bool up = lane & 16;
#pragma unroll
          for (int i = 0; i < 4; ++i) { const float mine = up ? a8[i + 4] : a8[i], oth = up ? a8[i] : a8[i + 4]; a4[i] = mine + __shfl_xor(oth, 16); } }
        { const bool up = lane & 8;
#pragma unroll
          for (int i = 0; i < 2; ++i) { const float mine = up ? a4[i + 2] : a4[i], oth = up ? a4[i] : a4[i + 2]; a2[i] = mine + __shfl_xor(oth, 8); } }
        { const bool up = lane & 4; const float mine = up ? a2[1] : a2[0], oth = up ? a2[0] : a2[1]; a1 = mine + __shfl_xor(oth, 4); }
        a1 += __shfl_xor(a1, 2); a1 += __shfl_xor(a1, 1);
        const float z = a1 + fb;
        const float ls = fminf(z, 0.f) - log1pf(expf(-fabsf(z)));
        if ((lane & 3) == 0) FLOG[(size_t)m * 16 + (lane >> 2)] = ls;
    }
}

__device__ __forceinline__ void p1_cscan(LAS unsigned char* lds, const Ptrs& P) {
    if (blockIdx.x >= 64) return;
    const int tid = threadIdx.x, lane = tid & 63, wave = tid >> 6;
    const int s = blockIdx.x, b = s >> 4, h = s & 15;
    const float* fl = (const float*)(P.ws + WS_FLOG) + (size_t)b * SEQ * 16 + h;
    float v[16]; float run = 0.f;
#pragma unroll
    for (int j = 0; j < 16; ++j) { run += fl[(size_t)(16 * tid + j) * 16]; v[j] = run; }
    float tot = run;
#pragma unroll
    for (int o = 1; o < 64; o <<= 1) { const float t = __shfl_up(tot, o); if (lane >= o) tot += t; }
    LAS float* wsum = (LAS float*)(lds + MISC_OFF);
    if (lane == 63) wsum[wave] = tot;
    __syncthreads();
    float base = 0.f;
#pragma unroll
    for (int w = 0; w < 8; ++w) if (w < wave) base += wsum[w];
    const float pre = base + tot - run;
    float* cl = (float*)(P.ws + WS_CL) + (size_t)s * SEQ + 16 * tid;
#pragma unroll
    for (int j = 0; j < 16; ++j) cl[j] = (pre + v[j]) * LOG2E;
    __syncthreads();
}

using pg8::Unit; using pg8::HALF; using pg8::BM;
struct EpiProj {
    static constexpr bool PERM = true, AFTER_DRAIN = false;
    bf16 *o0, *o1, *o2, *o3; int m0, m1, m2, m3; float scale0; const float* lbv;
    __device__ __forceinline__ void operator()(const f32x4 (&acc)[2][2][4][2], const Unit& u, int wr, int wc, int fr, int fq) const {
        const int colt = u.pn * BM, seg = colt >> 10, colin = colt & 1023;
        bf16* base = (bf16*)((uintptr_t)(seg == 0) * (uintptr_t)o0 + (uintptr_t)(seg == 1) * (uintptr_t)o1 + (uintptr_t)(seg == 2) * (uintptr_t)o2 + (uintptr_t)(seg == 3) * (uintptr_t)o3);
        const int mode = (seg == 0) * m0 + (seg == 1) * m1 + (seg == 2) * m2 + (seg == 3) * m3;
        const float sc = seg == 0 ? scale0 : 1.f;
        const int row0 = u.pm * BM + wr * 64 + fr, col0 = colin + wc * 32 + 8 * fq;
#pragma unroll
        for (int ai = 0; ai < 2; ++ai)
#pragma unroll
            for (int m = 0; m < 4; ++m) { bf16* rowp = base + (size_t)(row0 + ai * HALF + m * 16) * D + col0;
#pragma unroll
                for (int bj = 0; bj < 2; ++bj) { const f32x4 a0 = acc[ai][bj][m][0], a1 = acc[ai][bj][m][1];
                    float r[8] = {a0[0], a0[1], a0[2], a0[3], a1[0], a1[1], a1[2], a1[3]};
                    if (mode == 0) {
#pragma unroll
                        for (int q = 0; q < 8; ++q) r[q] *= sc;
                    } else if (mode == 1) {
#pragma unroll
                        for (int q = 0; q < 8; ++q) r[q] = r[q] * fsigmoid(r[q]);
                    } else {
                        const f32x4 l0 = *(const f32x4*)(lbv + col0 + bj * HALF), l1 = *(const f32x4*)(lbv + col0 + bj * HALF + 4);
                        const float l8[8] = {l0[0], l0[1], l0[2], l0[3], l1[0], l1[1], l1[2], l1[3]};
#pragma unroll
                        for (int q = 0; q < 8; ++q) r[q] = flog(l8[q] + (1.f - l8[q]) * fsigmoid(r[q]));
                    }
                    v4u w; w.x = pk2(r[0], r[1]); w.y = pk2(r[2], r[3]); w.z = pk2(r[4], r[5]); w.w = pk2(r[6], r[7]);
                    *(v4u*)(rowp + bj * HALF) = w; } }
    }
};
struct EpiGate {
    static constexpr bool PERM = true, AFTER_DRAIN = false;
    const bf16* gate; const bf16* add; bf16* out;
    __device__ __forceinline__ void operator()(const f32x4 (&acc)[2][2][4][2], const Unit& u, int wr, int wc, int fr, int fq) const {
        const int row0 = u.pm * BM + wr * 64 + fr, col0 = u.pn * BM + wc * 32 + 8 * fq;
#pragma unroll
        for (int ai = 0; ai < 2; ++ai)
#pragma unroll
            for (int m = 0; m < 4; ++m) { const size_t off = (size_t)(row0 + ai * HALF + m * 16) * D + col0;
#pragma unroll
                for (int bj = 0; bj < 2; ++bj) {
                    const v4u g = *(const v4u*)(gate + off + bj * HALF);
                    v4u a = (v4u){0u, 0u, 0u, 0u}; if (add) a = *(const v4u*)(add + off + bj * HALF);
                    const f32x4 v0 = acc[ai][bj][m][0], v1 = acc[ai][bj][m][1];
                    float r[8];
                    r[0] = bflo(a.x) + fsigmoid(bflo(g.x)) * v0[0]; r[1] = bfhi(a.x) + fsigmoid(bfhi(g.x)) * v0[1];
                    r[2] = bflo(a.y) + fsigmoid(bflo(g.y)) * v0[2]; r[3] = bfhi(a.y) + fsigmoid(bfhi(g.y)) * v0[3];
                    r[4] = bflo(a.z) + fsigmoid(bflo(g.z)) * v1[0]; r[5] = bfhi(a.z) + fsigmoid(bfhi(g.z)) * v1[1];
                    r[6] = bflo(a.w) + fsigmoid(bflo(g.w)) * v1[2]; r[7] = bfhi(a.w) + fsigmoid(bfhi(g.w)) * v1[3];
                    v4u w; w.x = pk2(r[0], r[1]); w.y = pk2(r[2], r[3]); w.z = pk2(r[4], r[5]); w.w = pk2(r[6], r[7]);
                    *(v4u*)(out + off + bj * HALF) = w; } }
    }
};
struct EpiRes {
    static constexpr bool PERM = false, AFTER_DRAIN = false;
    const float* base; float* out; bf16* xh; const float* gcol; float* ss;
    __device__ __forceinline__ void operator()(const f32x4 (&acc)[2][2][4][2], const Unit& u, int wr, int wc, int fr, int fq) const {
        const int col0 = u.pn * BM + wc * 32 + 4 * fq;
        f32x4 gv[2][2];
#pragma unroll
        for (int bj = 0; bj < 2; ++bj)
#pragma unroll
            for (int n = 0; n < 2; ++n) gv[bj][n] = xh ? *(const f32x4*)(gcol + col0 + bj * HALF + n * 16) : (f32x4){0.f, 0.f, 0.f, 0.f};
#pragma unroll
        for (int ai = 0; ai < 2; ++ai)
#pragma unroll
            for (int m = 0; m < 4; ++m) { const int row = u.pm * BM + ai * HALF + wr * 64 + m * 16 + fr; const size_t off = (size_t)row * D + col0; float s = 0.f;
#pragma unroll
                for (int bj = 0; bj < 2; ++bj)
#pragma unroll
                    for (int n = 0; n < 2; ++n) { const f32x4 h = *(const f32x4*)(base + off + bj * HALF + n * 16) + acc[ai][bj][m][n];
                        *(f32x4*)(out + off + bj * HALF + n * 16) = h; s += (h[0] * h[0] + h[1] * h[1]) + (h[2] * h[2] + h[3] * h[3]);
                        if (xh) { const f32x4 g = h * gv[bj][n]; v2u w; w.x = pk2(g[0], g[1]); w.y = pk2(g[2], g[3]); *(v2u*)(xh + off + bj * HALF + n * 16) = w; } }
                s += __shfl_xor(s, 16); s += __shfl_xor(s, 32);
                if (fq == 0) atomicAdd(ss + row, s);
                asm volatile("" ::: "memory"); }
    }
};
#define DPP_ROR1 0x121
#define DPP_ROR2 0x122
#define DPP_SHR1 0x111
#define DPP_SHR2 0x112
template <int CTRL> __device__ __forceinline__ float dppf(float old, float src) {
    return __builtin_bit_cast(float, __builtin_amdgcn_update_dpp(__builtin_bit_cast(int, old), __builtin_bit_cast(int, src), CTRL, 0xf, 0xf, false));
}
struct EpiConvGlu {
    static constexpr bool PERM = true, AFTER_DRAIN = false;
    bf16* hm; const float* ss1; const float* conv_w; const float* conv_b; LAS unsigned char* halo;
    __device__ __forceinline__ void operator()(const f32x4 (&acc)[2][2][4][2], const Unit& u, int wr, int wc, int fr, int fq) const {
        LAS f32x4* H = (LAS f32x4*)halo;
        const int grow0 = UP_TM * u.pm - 2 + wr * 64 + fr;
        float rs[2][4];
#pragma unroll
        for (int ai = 0; ai < 2; ++ai)
#pragma unroll
            for (int m = 0; m < 4; ++m) { int g = grow0 + ai * HALF + m * 16; g = g < 0 ? 0 : (g > M - 1 ? M - 1 : g); rs[ai][m] = 1.0f / sqrtf(ss1[g] * (1.f / D) + EPS); }
        if (fr >= 14) {
#pragma unroll
            for (int ai = 0; ai < 2; ++ai)
#pragma unroll
                for (int bj = 0; bj < 2; ++bj)
#pragma unroll
                    for (int n = 0; n < 2; ++n) H[((((ai * 2 + wr) * 2 + (fr - 14)) * 4 + wc) * 4 + fq) * 4 + bj * 2 + n] = acc[ai][bj][3][n] * rs[ai][3];
        }
        asm volatile("s_waitcnt lgkmcnt(0)\n\ts_barrier" ::: "memory");
        const int gc0 = u.pn * 128 + wc * 32 + 8 * fq;
#pragma unroll
        for (int n = 0; n < 2; ++n) {
            const int gc = gc0 + 4 * n;
            f32x4 w0[2], w1[2], w2[2], cb[2];
#pragma unroll
            for (int bj = 0; bj < 2; ++bj) { const int c = gc + bj * DFF; w0[bj] = *(const f32x4*)(conv_w + c); w1[bj] = *(const f32x4*)(conv_w + NUP + c); w2[bj] = *(const f32x4*)(conv_w + 2 * NUP + c); cb[bj] = *(const f32x4*)(conv_b + c); }
#pragma unroll
            for (int ai = 0; ai < 2; ++ai) {
                const int blk = ai * 2 + wr;
                f32x4 o1[2], o2[2];
#pragma unroll
                for (int bj = 0; bj < 2; ++bj) {
                    if (blk > 0) { o1[bj] = H[(((((blk - 1) * 2 + 1) * 4 + wc) * 4 + fq) * 4) + bj * 2 + n]; o2[bj] = H[(((((blk - 1) * 2 + (fr & 1)) * 4 + wc) * 4 + fq) * 4) + bj * 2 + n]; }
                    else { o1[bj] = (f32x4){0.f, 0.f, 0.f, 0.f}; o2[bj] = (f32x4){0.f, 0.f, 0.f, 0.f}; }
                }
                f32x4 prev[2];
#pragma unroll
                for (int m = 0; m < 4; ++m) {
                    const int i = ai * HALF + wr * 64 + m * 16 + fr, grow = UP_TM * u.pm - 2 + i, tt = grow & (SEQ - 1);
                    f32x4 y[2];
#pragma unroll
                    for (int bj = 0; bj < 2; ++bj) {
                        const f32x4 x = acc[ai][bj][m][n] * rs[ai][m];
#pragma unroll
                        for (int e = 0; e < 4; ++e) {
                            float p1, p2;
                            if (m == 0) { p1 = dppf<DPP_SHR1>(o1[bj][e], x[e]); p2 = dppf<DPP_SHR2>(o2[bj][e], x[e]); }
                            else { const float r1 = dppf<DPP_ROR1>(0.f, prev[bj][e]), r2 = dppf<DPP_ROR2>(0.f, prev[bj][e]); p1 = dppf<DPP_SHR1>(r1, x[e]); p2 = dppf<DPP_SHR2>(r2, x[e]); }
                            if (tt == 0) p1 = 0.f;
                            if (tt < 2) p2 = 0.f;
                            y[bj][e] = cb[bj][e] + w2[bj][e] * x[e] + w1[bj][e] * p1 + w0[bj][e] * p2;
                        }
                        prev[bj] = x;
                    }
                    const pg8::f32x2 ga = pg8::gelu_pk((pg8::f32x2){y[0][0], y[0][1]}), gb = pg8::gelu_pk((pg8::f32x2){y[0][2], y[0][3]});
                    v2u w; w.x = pk2(ga.x * y[1][0], ga.y * y[1][1]); w.y = pk2(gb.x * y[1][2], gb.y * y[1][3]);
                    if (i >= 2 && grow < M) *(v2u*)(hm + (size_t)grow * DFF + gc) = w;
                }
            }
        }
    }
};

__device__ __forceinline__ void hgrn_load_cumsum(const bf16* pf, float (&lf)[16], float (&bl)[16]) {
#pragma unroll
    for (int j = 0; j < 16; ++j) lf[j] = bf2f(pf[(size_t)j * D]);
    float run = 0.f;
#pragma unroll
    for (int j = 0; j < 16; ++j) { run += lf[j]; bl[j] = run; }
}
__device__ __forceinline__ void hgrn_vt_store(const bf16* pv, LAS bf16* VT, int k, int part) {
    unsigned short vv[16];
#pragma unroll
    for (int j = 0; j < 16; ++j) vv[j] = pv[(size_t)j * D];
    v4u w0, w1;
    w0.x = vv[0] | ((unsigned)vv[1] << 16); w0.y = vv[2] | ((unsigned)vv[3] << 16); w0.z = vv[4] | ((unsigned)vv[5] << 16); w0.w = vv[6] | ((unsigned)vv[7] << 16);
    w1.x = vv[8] | ((unsigned)vv[9] << 16); w1.y = vv[10] | ((unsigned)vv[11] << 16); w1.z = vv[12] | ((unsigned)vv[13] << 16); w1.w = vv[14] | ((unsigned)vv[15] << 16);
    *(LAS v4u*)(VT + k * 72 + 16 * part) = w0; *(LAS v4u*)(VT + k * 72 + 16 * part + 8) = w1;
}
__device__ __forceinline__ void hgrn_pass_a(LAS unsigned char* lds, const bf16* HLF, const bf16* HI, bf16* LS, float* DK, int G) {
    const int tid = threadIdx.x, lane = tid & 63, wave = tid >> 6, k = tid & 127, part = tid >> 7;
    LAS bf16* KT = (LAS bf16*)lds;
    LAS bf16* VT = (LAS bf16*)(lds + 18432);
    LAS float* SM = (LAS float*)(lds + 36864);
    for (int u = blockIdx.x; u < 4096; u += G) {
        const int bh = u >> 7, c = u & 127, b = bh >> 3, h = bh & 7;
        const size_t rowbase = (size_t)b * SEQ + c * 64 + 16 * part;
        float lf[16], bl[16];
        hgrn_load_cumsum(HLF + rowbase * D + h * 128 + k, lf, bl);
        SM[part * 128 + k] = bl[15];
        hgrn_vt_store(HI + rowbase * D + h * 128 + k, VT, k, part);
        __syncthreads();
        const float s0 = SM[k], s1 = SM[128 + k], s2 = SM[256 + k], s3 = SM[384 + k];
        const float tot = (s0 + s1) + (s2 + s3);
        const float pre = (part > 0 ? s0 : 0.f) + (part > 1 ? s1 : 0.f) + (part > 2 ? s2 : 0.f);
        unsigned pw[8];
#pragma unroll
        for (int j = 0; j < 16; j += 2) {
            const float k0 = (1.f - fexp(lf[j])) * fexp(tot - (pre + bl[j])), k1 = (1.f - fexp(lf[j + 1])) * fexp(tot - (pre + bl[j + 1]));
            pw[j >> 1] = pk2(k0, k1);
        }
        *(LAS v4u*)(KT + k * 72 + 16 * part) = (v4u){pw[0], pw[1], pw[2], pw[3]}; *(LAS v4u*)(KT + k * 72 + 16 * part + 8) = (v4u){pw[4], pw[5], pw[6], pw[7]};
        if (part == 0) DK[(size_t)u * 128 + k] = fexp(tot);
        __syncthreads();
        const int r = lane & 31, hh = lane >> 5, vi = wave >> 1;
#pragma unroll
        for (int q = 0; q < 2; ++q) {
            const int kj = 2 * (wave & 1) + q; f32x16 acc = {};
#pragma unroll
            for (int ks = 0; ks < 4; ++ks) {
                const bf16x8 a = *(const LAS bf16x8*)(VT + (32 * vi + r) * 72 + 16 * ks + 8 * hh);
                const bf16x8 bb = *(const LAS bf16x8*)(KT + (32 * kj + r) * 72 + 16 * ks + 8 * hh);
                acc = __builtin_amdgcn_mfma_f32_32x32x16_bf16(a, bb, acc, 0, 0, 0);
            }
            bf16* dst = LS + (size_t)u * 16384 + (32 * vi) * 128 + 32 * kj + r;
#pragma unroll
            for (int i = 0; i < 16; ++i) dst[crow(i, hh) * 128] = (bf16)f2bf(acc[i]);
        }
        __syncthreads();
    }
}
__device__ __forceinline__ void hgrn_pass_b(unsigned* LS32, const float* DK, int G) {
    const int gt = blockIdx.x * NTHR + threadIdx.x, NG = G * NTHR;
    for (int p = gt; p < 32 * 8192; p += NG) {
        const int bh = p >> 13, e2 = p & 8191, k = 2 * (e2 & 63);
        unsigned* ls = LS32 + (size_t)bh * 128 * 8192 + e2;
        const float* dk = DK + (size_t)bh * 128 * 128 + k;
        float s0 = 0.f, s1 = 0.f;
        for (int c0 = 0; c0 < 128; c0 += 8) {
            unsigned w[8]; float d0[8], d1[8];
#pragma unroll
            for (int i = 0; i < 8; ++i) { w[i] = ls[(size_t)(c0 + i) * 8192]; const float2 d = *(const float2*)(dk + (size_t)(c0 + i) * 128); d0[i] = d.x; d1[i] = d.y; }
#pragma unroll
            for (int i = 0; i < 8; ++i) { ls[(size_t)(c0 + i) * 8192] = pk2(s0, s1); s0 = d0[i] * s0 + bflo(w[i]); s1 = d1[i] * s1 + bfhi(w[i]); }
        }
    }
}
__device__ __forceinline__ void hgrn_pass_c(LAS unsigned char* lds, bf16* HQ, const bf16* HLF, const bf16* HI, const bf16* HG, const bf16* LS, const float* gnorm, int G) {
    const int tid = threadIdx.x, lane = tid & 63, wave = tid >> 6, k = tid & 127, part = tid >> 7;
    LAS bf16* QT = (LAS bf16*)lds;
    LAS bf16* KT2 = (LAS bf16*)(lds + 17408);
    LAS bf16* VT = (LAS bf16*)(lds + 34816);
    LAS float* OL = (LAS float*)(lds + 53248);
    LAS float* SM = (LAS float*)(lds + 87040);
    for (int u = blockIdx.x; u < 4096; u += G) {
        const int bh = u >> 7, c = u & 127, b = bh >> 3, h = bh & 7;
        const size_t row0 = (size_t)b * SEQ + c * 64, rowbase = row0 + 16 * part;
        float lf[16], bl[16];
        hgrn_load_cumsum(HLF + rowbase * D + h * 128 + k, lf, bl);
        SM[part * 128 + k] = bl[15];
        hgrn_vt_store(HI + rowbase * D + h * 128 + k, VT, k, part);
        float qs[16];
        { const bf16* pq = HQ + rowbase * D + h * 128 + k;
#pragma unroll
          for (int j = 0; j < 16; ++j) qs[j] = bf2f(pq[(size_t)j * D]); }
        __syncthreads();
        const float s0 = SM[k], s1 = SM[128 + k], s2 = SM[256 + k];
        const float pre = (part > 0 ? s0 : 0.f) + (part > 1 ? s1 : 0.f) + (part > 2 ? s2 : 0.f);
#pragma unroll
        for (int j = 0; j < 16; ++j) {
            const float bb = pre + bl[j];
            QT[(16 * part + j) * 136 + k] = (bf16)f2bf(qs[j] * fexp(bb));
            KT2[(16 * part + j) * 136 + k] = (bf16)f2bf((1.f - fexp(lf[j])) * fexp(-bb));
        }
        __syncthreads();
        const int r = lane & 31, hh = lane >> 5, ti = wave & 1, vj = wave >> 1;
        bf16x8 pa[2][2];
#pragma unroll
        for (int sj = 0; sj < 2; ++sj) { pa[sj][0] = (bf16x8){0, 0, 0, 0, 0, 0, 0, 0}; pa[sj][1] = pa[sj][0]; }
#pragma unroll
        for (int sj = 0; sj < 2; ++sj) {
            if (sj <= ti) {
                f32x16 x = {};
#pragma unroll
                for (int ks = 0; ks < 8; ++ks) {
                    const bf16x8 a = *(const LAS bf16x8*)(KT2 + (32 * sj + r) * 136 + 16 * ks + 8 * hh);
                    const bf16x8 bq = *(const LAS bf16x8*)(QT + (32 * ti + r) * 136 + 16 * ks + 8 * hh);
                    x = __builtin_amdgcn_mfma_f32_32x32x16_bf16(a, bq, x, 0, 0, 0);
                }
                if (sj == ti) {
#pragma unroll
                    for (int i = 0; i < 16; ++i) if (crow(i, hh) > r) x[i] = 0.f;
                }
#pragma unroll
                for (int s2 = 0; s2 < 2; ++s2) { v4u pw; pw.x = pk2(x[8 * s2], x[8 * s2 + 1]); pw.y = pk2(x[8 * s2 + 2], x[8 * s2 + 3]); pw.z = pk2(x[8 * s2 + 4], x[8 * s2 + 5]); pw.w = pk2(x[8 * s2 + 6], x[8 * s2 + 7]);
                    pa[sj][s2] = __builtin_bit_cast(bf16x8, pw); }
            }
        }
        f32x16 o = {};
        { const bf16* Sg = LS + (size_t)u * 16384 + (size_t)(32 * vj + r) * 128 + 8 * hh;
#pragma unroll
          for (int ks = 0; ks < 8; ++ks) {
              const bf16x8 a = *(const LAS bf16x8*)(QT + (32 * ti + r) * 136 + 16 * ks + 8 * hh);
              const bf16x8 bs = *(const bf16x8*)(Sg + 16 * ks);
              o = __builtin_amdgcn_mfma_f32_32x32x16_bf16(a, bs, o, 0, 0, 0);
          } }
#pragma unroll
        for (int sj = 0; sj < 2; ++sj) {
            if (sj <= ti) {
#pragma unroll
                for (int s2 = 0; s2 < 2; ++s2) {
                    const LAS bf16* vp = VT + (32 * vj + r) * 72 + 32 * sj + 16 * s2 + 4 * hh;
                    const s16x4 lo = *(const LAS s16x4*)vp, hi4 = *(const LAS s16x4*)(vp + 8);
                    const bf16x8 pb = (bf16x8){lo[0], lo[1], lo[2], lo[3], hi4[0], hi4[1], hi4[2], hi4[3]};
                    o = __builtin_amdgcn_mfma_f32_32x32x16_bf16(pa[sj][s2], pb, o, 0, 0, 0);
                }
            }
        }
#pragma unroll
        for (int i = 0; i < 16; ++i) OL[(32 * ti + crow(i, hh)) * 132 + 32 * vj + r] = o[i];
        __syncthreads();
        {
            const int t = tid >> 3, vp = tid & 7;
            f32x4 ov[4]; float ss = 0.f;
#pragma unroll
            for (int q = 0; q < 4; ++q) { ov[q] = *(const LAS f32x4*)(OL + t * 132 + 16 * vp + 4 * q); ss += (ov[q][0] * ov[q][0] + ov[q][1] * ov[q][1]) + (ov[q][2] * ov[q][2] + ov[q][3] * ov[q][3]); }
            ss += __shfl_xor(ss, 1); ss += __shfl_xor(ss, 2); ss += __shfl_xor(ss, 4);
            const float rstd = 1.0f / sqrtf(ss * (1.f / 128.f) + EPS);
            const size_t off = (row0 + t) * D + h * 128 + 16 * vp;
            const v4u g0 = *(const v4u*)(HG + off), g1 = *(const v4u*)(HG + off + 8);
            const f32x4* gn = (const f32x4*)(gnorm + 16 * vp);
            const f32x4 n0 = gn[0], n1 = gn[1], n2 = gn[2], n3 = gn[3];
            v4u w0, w1;
            w0.x = pk2(ov[0][0] * rstd * n0[0] * bflo(g0.x), ov[0][1] * rstd * n0[1] * bfhi(g0.x)); w0.y = pk2(ov[0][2] * rstd * n0[2] * bflo(g0.y), ov[0][3] * rstd * n0[3] * bfhi(g0.y));
            w0.z = pk2(ov[1][0] * rstd * n1[0] * bflo(g0.z), ov[1][1] * rstd * n1[1] * bfhi(g0.z)); w0.w = pk2(ov[1][2] * rstd * n1[2] * bflo(g0.w), ov[1][3] * rstd * n1[3] * bfhi(g0.w));
            w1.x = pk2(ov[2][0] * rstd * n2[0] * bflo(g1.x), ov[2][1] * rstd * n2[1] * bfhi(g1.x)); w1.y = pk2(ov[2][2] * rstd * n2[2] * bflo(g1.y), ov[2][3] * rstd * n2[3] * bfhi(g1.y));
            w1.z = pk2(ov[3][0] * rstd * n3[0] * bflo(g1.z), ov[3][1] * rstd * n3[1] * bfhi(g1.z)); w1.w = pk2(ov[3][2] * rstd * n3[2] * bflo(g1.w), ov[3][3] * rstd * n3[3] * bfhi(g1.w));
            *(v4u*)(HQ + off) = w0; *(v4u*)(HQ + off + 8) = w1;
        }
        __syncthreads();
    }
}
__device__ __forceinline__ void final_norm(float* out, const float* ss2, const float* g, int G) {
    const int tid = threadIdx.x, lane = tid & 63, wave = tid >> 6;
    const int gw = blockIdx.x * NWAVES + wave, NGW = G * NWAVES;
    f32x4 gm[4];
#pragma unroll
    for (int j = 0; j < 4; ++j) gm[j] = ((const f32x4*)g)[lane + 64 * j];
    for (int m = gw; m < M; m += NGW) {
        f32x4* xr = (f32x4*)(out + (size_t)m * D) + lane;
        const float rstd = 1.0f / sqrtf(ss2[m] * (1.f / D) + EPS);
#pragma unroll
        for (int j = 0; j < 4; ++j) xr[64 * j] = xr[64 * j] * rstd * gm[j];
    }
}

struct Args { const float* in[15]; float* out; unsigned char* ws; int ph_lo, ph_hi; };
#ifndef NOPH0
#define NOPH0 0
#endif
#ifndef NOPH1
#define NOPH1 0
#endif
#ifndef NOPH2
#define NOPH2 0
#endif
#ifndef NOPH3
#define NOPH3 0
#endif
#ifndef NOPH4
#define NOPH4 0
#endif
#ifndef NOPH5
#define NOPH5 0
#endif
#ifndef NOPH6
#define NOPH6 0
#endif
#ifndef NOPH7
#define NOPH7 0
#endif
#ifndef NOPH8
#define NOPH8 0
#endif
#ifndef NOPH9
#define NOPH9 0
#endif
#ifndef NOPH10
#define NOPH10 0
#endif
#ifndef NOPH11
#define NOPH11 0
#endif
#ifndef NOPH12
#define NOPH12 0
#endif
constexpr int N_PHASES = 13;
#ifndef MK_ONE_LAUNCH
#define MK_ONE_LAUNCH 1
#endif

__global__ void __launch_bounds__(NTHR, 2) hybrid_fwd(Args args) {
    extern __shared__ __attribute__((aligned(16))) unsigned char lds_raw[];
    LAS unsigned char* lds = (LAS unsigned char*)lds_raw;
    const int G = gridDim.x;
    Ptrs P;
    P.x = args.in[0]; P.norm_mix = args.in[1]; P.w_in = args.in[2]; P.fbias = args.in[3]; P.lblog = args.in[4]; P.hg_norm = args.in[5];
    P.w_a = args.in[6]; P.w_b = args.in[7]; P.w_o = args.in[8]; P.norm_ffn = args.in[9]; P.w_up = args.in[10]; P.conv_w = args.in[11]; P.conv_b = args.in[12];
    P.w_dn = args.in[13]; P.norm_final = args.in[14]; P.out = args.out; P.ws = args.ws;
    unsigned char* ws = args.ws;
    bf16* Wt_in = (bf16*)(ws + WS_WIN);
    bf16* S0 = (bf16*)(ws + WS_SLOT0); bf16* S1 = (bf16*)(ws + WS_SLOT0 + SLOT); bf16* S2 = (bf16*)(ws + WS_SLOT0 + 2 * SLOT); bf16* S3 = (bf16*)(ws + WS_SLOT0 + 3 * SLOT);
    bf16* S4 = (bf16*)(ws + WS_SLOT0 + 4 * SLOT); bf16* S5 = (bf16*)(ws + WS_SLOT0 + 5 * SLOT); bf16* S6 = (bf16*)(ws + WS_SLOT0 + 6 * SLOT); bf16* D0 = (bf16*)args.out;
    float* SS1 = (float*)(ws + WS_SS1); float* SS2 = (float*)(ws + WS_SS2);
    const int lo = args.ph_lo, hi = args.ph_hi;
#define IN(k) (lo <= (k) && (k) < hi)
#define SEAM(k) do { if (IN(k) && IN((k) + 1)) { cg::this_grid().sync(); } } while (0)

    if (IN(0) && !NOPH0) { p0_prologue(lds, P, G); }
    SEAM(0);
    if (IN(1) && !NOPH1) {
        p1_cscan(lds, P);
        pg8::Gemm g{S0, Wt_in + (size_t)4096 * D, M, 3072, D, 0}; pg8::StaticOrder S; S.init(M, 3072, G, (int)blockIdx.x);
        EpiProj E{S1, S2, S3, S3, 0, 0, 0, 0, attn_body::C2, nullptr};
        pg8::gemm_phase<EpiProj, pg8::StaticOrder, true, true>(lds, g, S, E);
    }
    SEAM(1);
    if (IN(2) && !NOPH2) {
        const attn_body::AttnTensors AT{(const attn_body::bf16*)S1, (const attn_body::bf16*)S2, (const attn_body::bf16*)S3, (attn_body::bf16*)S1, (const float*)(ws + WS_CL)};
        const attn_body::StaticOrder S(G, (int)blockIdx.x);
        attn_body::attn_phase<attn_body::StaticOrder>((char*)lds_raw, AT, S);
    }
    if (IN(3) && !NOPH3) {
        pg8::Gemm g{S0, Wt_in, M, 4096, D, 0}; pg8::StaticOrder S; S.init(M, 4096, G, (int)blockIdx.x);
        EpiProj E{S4, S5, S6, D0, 1, 2, 0, 1, 1.f, (const float*)(ws + WS_LBV)};
        pg8::gemm_phase<EpiProj, pg8::StaticOrder, true, true>(lds, g, S, E);
    }
    SEAM(3);
    if (IN(4) && !NOPH4) hgrn_pass_a(lds, S5, S6, S2, (float*)(ws + WS_DK), G);
    SEAM(4);
    if (IN(5) && !NOPH5) hgrn_pass_b((unsigned*)S2, (const float*)(ws + WS_DK), G);
    SEAM(5);
    if (IN(6) && !NOPH6) hgrn_pass_c(lds, S4, S5, S6, D0, S2, P.hg_norm, G);
    SEAM(6);
    if (IN(7) && !NOPH7) {
        pg8::Gemm g{S0, Wt_in + (size_t)7168 * D, M, 2048, D, 0}; pg8::StaticOrder S; S.init(M, 2048, G, (int)blockIdx.x);
        EpiProj E{S5, S6, S6, S6, 0, 0, 0, 0, 1.f, nullptr};
        pg8::gemm_phase<EpiProj, pg8::StaticOrder, true, true>(lds, g, S, E);
    }
    SEAM(7);
    if (IN(8) && !NOPH8) {
        { pg8::Gemm g{S4, (const bf16*)(ws + WS_WA), M, D, D, 0}; pg8::StaticOrder S; S.init(M, D, G, (int)blockIdx.x);
          EpiGate E{S5, nullptr, S5};
          pg8::gemm_phase<EpiGate, pg8::StaticOrder, true, true>(lds, g, S, E); }
        asm volatile("s_waitcnt vmcnt(0)" ::: "memory"); __builtin_amdgcn_fence(__ATOMIC_ACQUIRE, "agent"); asm volatile("s_waitcnt vmcnt(0)" ::: "memory"); __syncthreads();
        { pg8::Gemm g{S1, (const bf16*)(ws + WS_WB), M, D, D, 0}; pg8::StaticOrder S; S.init(M, D, G, (int)blockIdx.x);
          EpiGate E{S6, S5, S6};
          pg8::gemm_phase<EpiGate, pg8::StaticOrder, true, true>(lds, g, S, E); }
    }
    SEAM(8);
    if (IN(9) && !NOPH9) {
        pg8::Gemm g{S6, (const bf16*)(ws + WS_WO), M, D, D, 0}; pg8::StaticOrder S; S.init(M, D, G, (int)blockIdx.x);
        EpiRes E{P.x, P.out, S0, P.norm_ffn, SS1};
        pg8::gemm_phase<EpiRes, pg8::StaticOrder, true, true>(lds, g, S, E);
    }
    SEAM(9);
    if (IN(10) && !NOPH10) {
        pg8::Gemm g{S0 - 2 * D, (const bf16*)(ws + WS_WUP), UP_NM * 256, NUP, D, (size_t)UP_TM * D * 2}; pg8::StaticOrder S; S.init(UP_NM * 256, NUP, G, (int)blockIdx.x);
        EpiConvGlu E{S1, SS1, P.conv_w, P.conv_b, lds + HALO_OFF};
        pg8::gemm_phase<EpiConvGlu, pg8::StaticOrder, true, true>(lds, g, S, E);
    }
    SEAM(10);
    if (IN(11) && !NOPH11) {
        pg8::Gemm g{S1, (const bf16*)(ws + WS_WDN), M, D, DFF, 0}; pg8::StaticOrder S; S.init(M, D, G, (int)blockIdx.x);
        EpiRes E{P.out, P.out, nullptr, nullptr, SS2};
        pg8::gemm_phase<EpiRes, pg8::StaticOrder, true, true>(lds, g, S, E);
    }
    SEAM(11);
    if (IN(12) && !NOPH12) final_norm(P.out, SS2, P.norm_final, G);
#undef IN
#undef SEAM
}

extern "C" void kernel_launch(void* const* d_in, const int* in_sizes, int n_in, void* d_out, int out_size, void* d_ws, size_t ws_size, hipStream_t stream) {
    static int grid = 0;
    if (grid == 0) {
        if (n_in != 15 || in_sizes[0] != M * D || out_size != M * D || ws_size < WS_END) { fprintf(stderr, "kernel_launch: unexpected shapes / workspace (%d inputs, in0 %d, out %d, ws %zu < %zu)\n", n_in, n_in > 0 ? in_sizes[0] : -1, out_size, ws_size, (size_t)WS_END); grid = -1; return; }
        int dev = 0, cus = 0, per_cu = 0;
        if (hipGetDevice(&dev) != hipSuccess || hipDeviceGetAttribute(&cus, hipDeviceAttributeMultiprocessorCount, dev) != hipSuccess) { grid = -1; return; }
        if (hipFuncSetAttribute((const void*)hybrid_fwd, hipFuncAttributeMaxDynamicSharedMemorySize, LDS_BYTES) != hipSuccess) { fprintf(stderr, "kernel_launch: hipFuncSetAttribute failed\n"); grid = -1; return; }
        if (hipOccupancyMaxActiveBlocksPerMultiprocessor(&per_cu, (const void*)hybrid_fwd, NTHR, LDS_BYTES) != hipSuccess || per_cu < 1) per_cu = 1;
        (void)hipGetLastError();
        grid = cus;
    }
    if (grid < 0) return;
    Args a{};
    for (int i = 0; i < 15; ++i) a.in[i] = (const float*)d_in[i];
    a.out = (float*)d_out; a.ws = (unsigned char*)d_ws;
#if MK_ONE_LAUNCH
    a.ph_lo = 0; a.ph_hi = N_PHASES;
    void* kargs[] = {&a};
    hipError_t e = hipLaunchCooperativeKernel((const void*)hybrid_fwd, dim3(grid), dim3(NTHR), kargs, LDS_BYTES, stream);
    if (e != hipSuccess) fprintf(stderr, "cooperative launch failed: %s (grid %d)\n", hipGetErrorString(e), grid);
#else
    for (int p = 0; p < N_PHASES; ++p) { a.ph_lo = p; a.ph_hi = p + 1; hipLaunchKernelGGL(hybrid_fwd, dim3(grid), dim3(NTHR), LDS_BYTES, stream, a); }
#endif
}
```

```cpp
#include <hip/hip_runtime.h>
#include <hip/hip_cooperative_groups.h>
#include <hip/hip_runtime.h>
#include <cstdio>
#include <cstdint>
namespace pg8 {
#define PG8_LAS __attribute__((address_space(3)))
typedef unsigned short bf16_t;
typedef short bf16x8 __attribute__((ext_vector_type(8)));
typedef float f32x4 __attribute__((ext_vector_type(4)));
typedef unsigned u32x4 __attribute__((ext_vector_type(4)));
constexpr int BM = 256, BK = 64, HALF = 128, HTB = HALF * BK * 2  , STAGE_BYTES = 8 * HTB, NXCD = 8, WGM = 8;

__host__ __device__ __forceinline__ int lds_byte(int r, int c) { const int st = (r >> 4) * 2 + (c >> 5), rr = r & 15, cc = c & 31, ob = rr * 64 + cc * 2; return st * 1024 + (ob ^ (((ob >> 9) & 1) << 5)); }
__host__ __device__ __forceinline__ void stage_rc(int b, int& R, int& C) { const int st = b / 1024, sb = b % 1024, swz = sb ^ (((sb >> 9) & 1) << 5); R = (st >> 1) * 16 + swz / 64; C = (st & 1) * 32 + (swz % 64) / 2; }
__host__ __device__ __forceinline__ int perm32(int rho) { const int n = rho >> 4, i = rho & 15; return 8 * (i >> 2) + 4 * n + (i & 3); }

struct Unit { int pm, pn; };
struct Gemm { const bf16_t* A; const bf16_t* Bt; int M, N, K; size_t a_tstep; };

struct StaticOrder {
    int nM, nN, nwg, G, c;
    __host__ __device__ void init(int M, int N, int G_, int c_) { nM = M / BM; nN = N / BM; nwg = nM * nN; G = G_; c = c_; }
    __host__ __device__ bool next(int i, Unit& u) const {
        const long L = (long)i * G + c; if (L >= nwg) return false;
        int wgid = (int)L; { const int q = nwg / NXCD, r = nwg % NXCD, xcd = wgid % NXCD, off = wgid / NXCD; wgid = (xcd < r ? xcd * (q + 1) : r * (q + 1) + (xcd - r) * q) + off; }
        const int nig = WGM * nN, gid = wgid / nig, fm = gid * WGM, gsz = (nM - fm) < WGM ? (nM - fm) : WGM;
        u.pm = fm + ((wgid % nig) % gsz); u.pn = (wgid % nig) / gsz; return true;
    }
    __device__ __forceinline__ void a_ready(const Unit&) const {}
    __device__ __forceinline__ void done(const Unit&) const {}
};

__device__ __forceinline__ unsigned cvt_pk_bf16(float lo, float hi) { unsigned r; asm volatile("v_cvt_pk_bf16_f32 %0, %1, %2" : "=v"(r) : "v"(lo), "v"(hi)); return r; }
typedef float f32x2 __attribute__((ext_vector_type(2)));
__device__ __forceinline__ f32x2 gelu_pk(f32x2 v) {
    const f32x2 av = __builtin_elementwise_abs(v), d = av * 0.2316418882f + 1.0f;
    f32x2 t; t.x = __builtin_amdgcn_rcpf(d.x); t.y = __builtin_amdgcn_rcpf(d.y);
    f32x2 q = t * 0.5307027145f + (-0.7265760135f); q = q * t + 0.7107068705f; q = q * t + (-0.142248368f); q = q * t + 0.127414796f; q = q * t;
    const f32x2 s = (v * v) * (-0.72134752044f);
    f32x2 e; e.x = __builtin_amdgcn_exp2f(s.x); e.y = __builtin_amdgcn_exp2f(s.y);
    const f32x2 m = v * (q * e), r = v - m;
    f32x2 o; o.x = v.x < 0.f ? m.x : r.x; o.y = v.y < 0.f ? m.y : r.y; return o;
}

template <class Epi, class Sched, bool ALIGN_EPI = false, bool SP2 = false>
__device__ __forceinline__ void gemm_phase(PG8_LAS unsigned char* lds, const Gemm g, const Sched& S, const Epi& E) {
    int tid_ = threadIdx.x; asm volatile("" : "+v"(tid_));
    const int tid = tid_, wid = __builtin_amdgcn_readfirstlane(tid >> 6), lane = tid & 63, wr = wid >> 2, wc = wid & 3, fr = lane & 15, fq = lane >> 4;
    const int K = g.K, nt = K / BK;
    unsigned voffA[2], voffB[2];
#pragma unroll
    for (int i = 0; i < 2; ++i) { int R, C; stage_rc(tid * 16 + i * 8192, R, C); const int Rb = Epi::PERM ? ((R & ~31) + perm32(R & 31)) : R;
        voffA[i] = (unsigned)(R * K + C) * 2u; voffB[i] = (unsigned)(Rb * K + C) * 2u; }
    const size_t kstep = (size_t)(BK * 2);
    const size_t hstep = (size_t)HALF * K * 2;
    const size_t tstep = 2 * hstep;
    const unsigned ldsw = (unsigned)wid * 1024u;
    const int aoff = lds_byte(wr * 64 + fr, fq * 8), boff = lds_byte(wc * 32 + fr, fq * 8);
#define PG8_SA(b, h) (((b) * 2 + (h)) * HTB)
#define PG8_SB(b, h) ((4 + (b) * 2 + (h)) * HTB)
#define PG8_STAGE(bufoff, gbase, voff) do { _Pragma("unroll") for (int _i = 0; _i < 2; ++_i) \
        __builtin_amdgcn_global_load_lds((const unsigned*)((const char*)(gbase) + (voff)[_i]), (PG8_LAS unsigned*)(lds + (bufoff) + ldsw + _i * 8192), 16, 0, 0); } while (0)
#define PG8_LDA(dst, b, h) do { _Pragma("unroll") for (int m = 0; m < 4; ++m) _Pragma("unroll") for (int k = 0; k < 2; ++k) dst[m][k] = *(const PG8_LAS bf16x8*)(lds + PG8_SA(b, h) + aoff + m * 2048 + k * 1024); } while (0)
#define PG8_LDB(dst, b, h) do { _Pragma("unroll") for (int n = 0; n < 2; ++n) _Pragma("unroll") for (int k = 0; k < 2; ++k) dst[n][k] = *(const PG8_LAS bf16x8*)(lds + PG8_SB(b, h) + boff + n * 2048 + k * 1024); } while (0)
#define PG8_MMA(ai, bj, At, Bt) do { __builtin_amdgcn_s_setprio(1); _Pragma("unroll") for (int m = 0; m < 4; ++m) _Pragma("unroll") for (int n = 0; n < 2; ++n) _Pragma("unroll") for (int k = 0; k < 2; ++k) \
        acc[ai][bj][m][n] = __builtin_amdgcn_mfma_f32_16x16x32_bf16(Bt[n][k], At[m][k], acc[ai][bj][m][n], 0, 0, 0); __builtin_amdgcn_s_setprio(0); } while (0)
#define PG8_WAIT_V(n) asm volatile("s_waitcnt vmcnt(" #n ")" ::: "memory")
#define PG8_WAIT_L(n) asm volatile("s_waitcnt lgkmcnt(" #n ")" ::: "memory")
#define PG8_BAR __builtin_amdgcn_s_barrier()
#define PG8_SCHED __builtin_amdgcn_sched_barrier(0)
    Unit cur, nxt; int ui = 0;
    if (!S.next(0, cur)) return;
    f32x4 acc[2][2][4][2];
#pragma unroll
    for (int a = 0; a < 2; ++a)
#pragma unroll
        for (int b = 0; b < 2; ++b)
#pragma unroll
            for (int m = 0; m < 4; ++m)
#pragma unroll
                for (int n = 0; n < 2; ++n) acc[a][b][m][n] = (f32x4){0.f, 0.f, 0.f, 0.f};
    bf16x8 At[4][2], B0[2][2], B1[2][2];
    const size_t tstepA = g.a_tstep ? g.a_tstep : tstep; const char* cA = (const char*)g.A + (size_t)cur.pm * tstepA; const char* cB = (const char*)g.Bt + (size_t)cur.pn * tstep;
    S.a_ready(cur);
    if constexpr (SP2) {
        PG8_STAGE(PG8_SB(0, 0), cB, voffB); PG8_STAGE(PG8_SB(0, 1), cB + hstep, voffB); PG8_STAGE(PG8_SA(0, 0), cA, voffA); PG8_STAGE(PG8_SA(0, 1), cA + hstep, voffA);
        if (wr == 1) PG8_BAR;
        PG8_WAIT_V(2); PG8_BAR;
        PG8_STAGE(PG8_SB(1, 0), cB + kstep, voffB); PG8_STAGE(PG8_SA(1, 0), cA + kstep, voffA); PG8_STAGE(PG8_SB(1, 1), cB + hstep + kstep, voffB);
        PG8_WAIT_V(6); PG8_BAR;
    } else {
        PG8_STAGE(PG8_SB(0, 0), cB, voffB); PG8_STAGE(PG8_SA(0, 0), cA, voffA); PG8_STAGE(PG8_SB(0, 1), cB + hstep, voffB); PG8_STAGE(PG8_SA(0, 1), cA + hstep, voffA);
        if (wr == 1) PG8_BAR;
        PG8_WAIT_V(4); PG8_BAR;
        PG8_STAGE(PG8_SB(1, 0), cB + kstep, voffB); PG8_STAGE(PG8_SA(1, 0), cA + kstep, voffA); PG8_STAGE(PG8_SB(1, 1), cB + hstep + kstep, voffB);
        PG8_WAIT_V(6); PG8_BAR;
    }
    for (;;) {
        const bool has_next = S.next(ui + 1, nxt);
        const char* nA = has_next ? (const char*)g.A + (size_t)nxt.pm * tstepA : cA; const char* nB = has_next ? (const char*)g.Bt + (size_t)nxt.pn * tstep : cB;
        for (int t = 0; t < nt; t += 2) {
            const bool last = (t == nt - 2);
            const char* a1 = cA + (size_t)(t + 1) * kstep;
            const char* a2 = last ? nA : cA + (size_t)(t + 2) * kstep; const char* b2 = last ? nB : cB + (size_t)(t + 2) * kstep;
            const char* a3 = a2 + kstep; const char* b3 = b2 + kstep;
            if (last && has_next) S.a_ready(nxt);
            if constexpr (SP2) {
            PG8_LDB(B0, 0, 0); PG8_LDB(B1, 0, 1); PG8_SCHED; PG8_LDA(At, 0, 0); PG8_STAGE(PG8_SA(1, 1), a1 + hstep, voffA);
            PG8_WAIT_V(8); PG8_WAIT_L(0); PG8_BAR; PG8_MMA(0, 0, At, B0); PG8_MMA(0, 1, At, B1); PG8_BAR; PG8_SCHED;
            PG8_LDA(At, 0, 1); PG8_STAGE(PG8_SB(0, 0), b2, voffB); PG8_STAGE(PG8_SB(0, 1), b2 + hstep, voffB); PG8_STAGE(PG8_SA(0, 0), a2, voffA);
            PG8_WAIT_V(8); PG8_WAIT_L(0); PG8_BAR; PG8_MMA(1, 0, At, B0); PG8_MMA(1, 1, At, B1); PG8_BAR; PG8_SCHED;
            PG8_LDB(B0, 1, 0); PG8_LDB(B1, 1, 1); PG8_SCHED; PG8_LDA(At, 1, 0); PG8_STAGE(PG8_SA(0, 1), a2 + hstep, voffA);
            PG8_WAIT_V(8); PG8_WAIT_L(0); PG8_BAR; PG8_MMA(0, 0, At, B0); PG8_MMA(0, 1, At, B1); PG8_BAR; PG8_SCHED;
            PG8_LDA(At, 1, 1); PG8_STAGE(PG8_SB(1, 0), b3, voffB); PG8_STAGE(PG8_SB(1, 1), b3 + hstep, voffB); PG8_STAGE(PG8_SA(1, 0), a3, voffA);
            PG8_WAIT_V(8); PG8_WAIT_L(0); PG8_BAR; PG8_MMA(1, 0, At, B0); PG8_MMA(1, 1, At, B1); PG8_BAR; PG8_SCHED;
            } else {
            PG8_LDB(B0, 0, 0); PG8_SCHED; PG8_LDA(At, 0, 0); PG8_STAGE(PG8_SA(1, 1), a1 + hstep, voffA);
            PG8_WAIT_L(8); PG8_BAR; PG8_WAIT_L(0); PG8_MMA(0, 0, At, B0); PG8_BAR; PG8_SCHED;
            PG8_LDB(B1, 0, 1); PG8_STAGE(PG8_SB(0, 0), b2, voffB);
            PG8_BAR; PG8_WAIT_L(0); PG8_MMA(0, 1, At, B1); PG8_BAR;
            PG8_LDA(At, 0, 1); PG8_STAGE(PG8_SA(0, 0), a2, voffA);
            PG8_BAR; PG8_WAIT_L(0); PG8_MMA(1, 0, At, B0); PG8_BAR; PG8_SCHED;
            PG8_STAGE(PG8_SB(0, 1), b2 + hstep, voffB);
            PG8_WAIT_V(6); PG8_BAR; PG8_MMA(1, 1, At, B1); PG8_BAR;
            PG8_LDB(B0, 1, 0); PG8_SCHED; PG8_LDA(At, 1, 0); PG8_STAGE(PG8_SA(0, 1), a2 + hstep, voffA);
            PG8_WAIT_L(8); PG8_BAR; PG8_WAIT_L(0); PG8_MMA(0, 0, At, B0); PG8_BAR; PG8_SCHED;
            PG8_LDB(B1, 1, 1); PG8_STAGE(PG8_SB(1, 0), b3, voffB);
            PG8_BAR; PG8_WAIT_L(0); PG8_MMA(0, 1, At, B1); PG8_BAR;
            PG8_LDA(At, 1, 1); PG8_STAGE(PG8_SA(1, 0), a3, voffA);
            PG8_BAR; PG8_WAIT_L(0); PG8_MMA(1, 0, At, B0); PG8_BAR; PG8_SCHED;
            PG8_STAGE(PG8_SB(1, 1), b3 + hstep, voffB);
            PG8_WAIT_V(6); PG8_BAR; PG8_MMA(1, 1, At, B1); PG8_BAR;
            }
        }
        if constexpr (ALIGN_EPI) { if (wr == 0) PG8_BAR; }
        if constexpr (!Epi::AFTER_DRAIN) { E(acc, cur, wr, wc, fr, fq); S.done(cur); }
        if (!has_next) break;
#pragma unroll
        for (int a = 0; a < 2; ++a)
#pragma unroll
            for (int b = 0; b < 2; ++b)
#pragma unroll
                for (int m = 0; m < 4; ++m)
#pragma unroll
                    for (int n = 0; n < 2; ++n) acc[a][b][m][n] = (f32x4){0.f, 0.f, 0.f, 0.f};
        cur = nxt; cA = nA; cB = nB; ++ui;
        if constexpr (ALIGN_EPI) { if (wr == 1) PG8_BAR; }
    }
    PG8_WAIT_V(0);
    if constexpr (!ALIGN_EPI) { if (wr == 0) PG8_BAR; }
    PG8_BAR;
    if constexpr (Epi::AFTER_DRAIN) { E.fused(acc, cur, wr, wc, fr, fq, lds, wid, lane); S.done(cur); }
#undef PG8_SA
#undef PG8_SB
#undef PG8_STAGE
#undef PG8_LDA
#undef PG8_LDB
#undef PG8_MMA
#undef PG8_WAIT_V
#undef PG8_WAIT_L
#undef PG8_BAR
#undef PG8_SCHED
}
}

#ifndef PG8_SP2
#define PG8_SP2 true
#endif
#ifndef PG8_ALIGN
#define PG8_ALIGN true
#endif
#include <hip/hip_bf16.h>
#include <cmath>
namespace attn_body {
using bf16=__hip_bfloat16;
using bf16x8=__attribute__((ext_vector_type(8)))short;
using s16x4=__attribute__((ext_vector_type(4)))short;
using f32x16=__attribute__((ext_vector_type(16)))float;
using u32x4=__attribute__((ext_vector_type(4)))unsigned;
constexpr int BATCH=4,NHEAD=16,SEQ=8192,D=64,DM=NHEAD*D;
constexpr int NW=8,QBLK=32,QB=QBLK*NW,KVBLK=64,NQB=SEQ/QB;
constexpr int ATTN_PITCH=DM, ATTN_UNIT_ROWS=QB;
__device__ __forceinline__ int crow(int r,int hi){return (r&3)+8*(r>>2)+4*hi;}
#define SBAR() __builtin_amdgcn_sched_barrier(0)
__device__ __forceinline__ void cmask(f32x16&p0,f32x16&p1,int jb,int qrel,int hi){
  const float NEG=-INFINITY; int kb=64*jb+4*hi;
  #pragma unroll
  for(int r=0;r<16;++r){int kv=kb+(r&3)+8*(r>>2); if(kv>qrel)p0[r]=NEG; if(kv+32>qrel)p1[r]=NEG;}
}

constexpr int NSLOT=3, SLOTB=8192;
constexpr int LDS_K=0, LDS_V=NSLOT*SLOTB, LDS_WS=2*NSLOT*SLOTB, LDS_OST=LDS_WS+NW*64*4, LDS_CB=LDS_OST+NW*4096, LDS_BYTES=LDS_CB+SEQ*8;
constexpr float C2=0.125f*1.4426950408889634f;
__device__ __forceinline__ void glds16(const void*gsrc,unsigned lds_dst){unsigned keep;
  asm volatile("s_mov_b32 %0, m0\n\ts_mov_b32 m0, %2\n\ts_nop 0\n\tglobal_load_lds_dwordx4 %1, off\n\ts_mov_b32 m0, %0":"=&s"(keep):"v"(gsrc),"s"(lds_dst):"memory");}
__device__ __forceinline__ float max3f(float a,float b,float c){float r;asm("v_max3_f32 %0, %1, %2, %3":"=v"(r):"v"(a),"v"(b),"v"(c));return r;}
__device__ __forceinline__ float max2f(float a,float b){float r;asm("v_max_f32_e32 %0, %1, %2":"=v"(r):"v"(a),"v"(b));return r;}
__device__ __forceinline__ float fadd_s(float a,float b){float r;asm("v_add_f32_e32 %0, %1, %2":"=v"(r):"v"(a),"v"(b));return r;}
__device__ __forceinline__ float fsub_s(float a,float b){float r;asm("v_sub_f32_e32 %0, %1, %2":"=v"(r):"v"(a),"v"(b));return r;}
typedef float f32x2_t __attribute__((ext_vector_type(2))); typedef float f32x4_t __attribute__((ext_vector_type(4))); typedef __bf16 bf16x2_t __attribute__((ext_vector_type(2)));
__device__ __forceinline__ unsigned cvtpk_s(float lo,float hi){f32x2_t v={lo,hi};bf16x2_t b=__builtin_convertvector(v,bf16x2_t);return __builtin_bit_cast(unsigned,b);}
#define WAIT_BAR(N) asm volatile("s_waitcnt vmcnt(" #N ") lgkmcnt(0)\n\ts_barrier":::"memory")

__device__ __forceinline__ void qkt(f32x16&p0,f32x16&p1,const char*Kslot,const bf16x8*qr,const f32x16&negm,int r32,int hi){
  const char*kb=Kslot+hi*1024+r32*16;
  #pragma unroll
  for(int d0=0;d0<4;++d0){
    const bf16x8 b0=*reinterpret_cast<const bf16x8*>(kb+d0*2048);
    const bf16x8 b1=*reinterpret_cast<const bf16x8*>(kb+d0*2048+512);
    if(d0==0){p0=__builtin_amdgcn_mfma_f32_32x32x16_bf16(b0,qr[0],negm,0,0,0);p1=__builtin_amdgcn_mfma_f32_32x32x16_bf16(b1,qr[0],negm,0,0,0);}
    else{p0=__builtin_amdgcn_mfma_f32_32x32x16_bf16(b0,qr[d0],p0,0,0,0);p1=__builtin_amdgcn_mfma_f32_32x32x16_bf16(b1,qr[d0],p1,0,0,0);}}
}
typedef __attribute__((address_space(3))) const char* lds_cptr;
typedef short v4i16_t __attribute__((ext_vector_type(4)));
__device__ __forceinline__ void kload8(bf16x8*kf,lds_cptr kp){
  kf[0]=*(const __attribute__((address_space(3))) bf16x8*)(kp);      kf[1]=*(const __attribute__((address_space(3))) bf16x8*)(kp+512);
  kf[2]=*(const __attribute__((address_space(3))) bf16x8*)(kp+2048); kf[3]=*(const __attribute__((address_space(3))) bf16x8*)(kp+2560);
  kf[4]=*(const __attribute__((address_space(3))) bf16x8*)(kp+4096); kf[5]=*(const __attribute__((address_space(3))) bf16x8*)(kp+4608);
  kf[6]=*(const __attribute__((address_space(3))) bf16x8*)(kp+6144); kf[7]=*(const __attribute__((address_space(3))) bf16x8*)(kp+6656);
}
__device__ __forceinline__ void kload2(bf16x8*kf,lds_cptr kp,int j){ kf[2*j]=*(const __attribute__((address_space(3))) bf16x8*)(kp+j*2048); kf[2*j+1]=*(const __attribute__((address_space(3))) bf16x8*)(kp+j*2048+512); }
__device__ __forceinline__ s16x4 vtr(lds_cptr p){ return __builtin_bit_cast(s16x4,__builtin_amdgcn_ds_read_tr16_b64_v4i16((__attribute__((address_space(3))) v4i16_t*)p)); }
__device__ __forceinline__ float rowmax(const f32x16&p0,const f32x16&p1){
  float a=max3f(p0[0],p0[1],p1[0]),b=max3f(p0[2],p0[3],p1[1]);a=max3f(a,p1[2],p1[3]);
  #pragma unroll
  for(int r=4;r<16;r+=4){a=max3f(a,p0[r],p0[r+1]);b=max3f(b,p0[r+2],p0[r+3]);a=max3f(a,p1[r],p1[r+1]);b=max3f(b,p1[r+2],p1[r+3]);}
  const float m=max2f(a,b);
  auto rr=__builtin_amdgcn_permlane32_swap(__float_as_uint(m),__float_as_uint(m),false,false);
  return max2f(__uint_as_float(rr[0]),__uint_as_float(rr[1]));
}
__device__ __forceinline__ void pv(f32x16*o,int vb,bf16x8 pa0,bf16x8 pa1,bf16x8 pa2,bf16x8 pa3){
  #pragma unroll
  for(int d0=0;d0<2;++d0){s16x4 lo[4],hi[4];
    #pragma unroll
    for(int ks=0;ks<4;++ks){
      asm volatile("ds_read_b64_tr_b16 %0,%1 offset:%c2":"=&v"(lo[ks]):"v"(vb),"i"(d0*4096+ks*1024):"memory");
      asm volatile("ds_read_b64_tr_b16 %0,%1 offset:%c2":"=&v"(hi[ks]):"v"(vb),"i"(d0*4096+ks*1024+512):"memory");}
    asm volatile("s_waitcnt lgkmcnt(0)":::"memory");SBAR();
    #define PK(k) (bf16x8){lo[k][0],lo[k][1],lo[k][2],lo[k][3],hi[k][0],hi[k][1],hi[k][2],hi[k][3]}
    o[d0]=__builtin_amdgcn_mfma_f32_32x32x16_bf16(pa0,PK(0),o[d0],0,0,0);
    o[d0]=__builtin_amdgcn_mfma_f32_32x32x16_bf16(pa1,PK(1),o[d0],0,0,0);
    o[d0]=__builtin_amdgcn_mfma_f32_32x32x16_bf16(pa2,PK(2),o[d0],0,0,0);
    o[d0]=__builtin_amdgcn_mfma_f32_32x32x16_bf16(pa3,PK(3),o[d0],0,0,0);
    #undef PK
  }
}

#ifndef ATTN_STORE16
#define ATTN_STORE16(p,v) (*(u32x4*)(p)=(v))
#endif
template<int THRL> __device__ __forceinline__ void attn_unit(int b,int h,int qb,const bf16*Q,const bf16*__restrict__ K,const bf16*__restrict__ V,bf16*O,const float*__restrict__ CLbh,char*shm){
  const int tid=threadIdx.x,lane=tid&63,r32=lane&31,hi=lane>>5; const int wid=__builtin_amdgcn_readfirstlane(tid>>6);
  const long rowbase=(long)b*SEQ; const int q0=qb*QB;
  const bf16*Qw=Q+(rowbase+q0+wid*QBLK)*DM+h*D;
  const bf16*Kh=K+rowbase*DM+h*D,*Vh=V+rowbase*DM+h*D;
  const unsigned lds0=(unsigned)(uintptr_t)shm;
  float*wsf=(float*)(shm+LDS_WS)+wid*64;
  const bf16*ksrc=Kh+(long)lane*DM+wid*8;
  const bf16*vsrc=Vh+(long)(16*(wid&3)+(lane>>2))*DM+(wid>>2)*32+(lane&3)*8;
  const unsigned kdst=lds0+LDS_K+wid*1024, vdst=lds0+LDS_V+wid*1024;
  #define DMA_K(t,slot) glds16(ksrc+(long)(t)*KVBLK*DM,(unsigned)__builtin_amdgcn_readfirstlane(kdst+(slot)))
  #define DMA_V(t,slot) glds16(vsrc+(long)(t)*KVBLK*DM,(unsigned)__builtin_amdgcn_readfirstlane(vdst+(slot)))
  const char*Kbase=shm+LDS_K; bf16x8 kf[8];
  const lds_cptr shm3=(lds_cptr)shm; const lds_cptr kp0=shm3+LDS_K+hi*1024+r32*16; const lds_cptr vp0=shm3+LDS_V+((lane>>4)&1)*32+(lane&3)*8+(4*hi+((lane&15)>>2))*64;
  const int NT=(q0+QB)/KVBLK;
  { const float cref=CLbh[q0+QB-1]; unsigned long long*cbw=(unsigned long long*)(shm+LDS_CB);
    for(int i_=tid;i_<q0+QB;i_+=NW*64){ const float v_=cref-CLbh[i_]; const unsigned b1_=cvtpk_s(v_,0.f)&0xffffu; const float r1_=v_-__uint_as_float(b1_<<16);
      const unsigned b2_=cvtpk_s(r1_,0.f)&0xffffu; const float r2_=r1_-__uint_as_float(b2_<<16); const unsigned b3_=cvtpk_s(r2_,0.f)&0xffffu;
      cbw[i_]=(unsigned long long)(b1_|(b2_<<16))|((unsigned long long)b3_<<32); }
    asm volatile("s_waitcnt vmcnt(0) lgkmcnt(0)\n\ts_barrier":::"memory"); }
  const lds_cptr cbp0=(lds_cptr)shm+LDS_CB+r32*8;
  const short one_=(hi==0)?(short)0x3f80:(short)0; const bf16x8 ones=(bf16x8){one_,one_,one_,0,0,0,0,0};
  #define BLD(t,k) ({ const s16x4 lo_=*(const __attribute__((address_space(3))) s16x4*)(cbp0+(t)*512+(k)*256); (bf16x8){lo_[0],lo_[1],lo_[2],lo_[3],0,0,0,0}; })
  DMA_K(0,0);DMA_V(0,0);DMA_K(1,SLOTB);
  bf16x8 qr[4];
  #pragma unroll
  for(int d0=0;d0<4;++d0)qr[d0]=*reinterpret_cast<const bf16x8*>(&Qw[(long)r32*DM+d0*16+hi*8]);
  float mhat=0.f,l_reg=0.f;f32x16 o[2];o[0]=f32x16{};o[1]=f32x16{};f32x16 negm=f32x16{};asm volatile("":"+v"(negm));
  const int qrel=wid*QBLK+r32;
  #define CMASK(P0,P1,t) do{int jb_=(t)-(NT-4); if(jb_>=0)cmask(P0,P1,jb_,qrel,hi);}while(0)
  bool resc=false;
  #define START(P0,P1) do{ const float rm=rowmax(P0,P1); resc=false; \
    { const float dl=rm; mhat=fadd_s(mhat,dl); \
      _Pragma("unroll") for(int r=0;r<16;++r){P0[r]=fsub_s(P0[r],dl);P1[r]=fsub_s(P1[r],dl);} \
      _Pragma("unroll") for(int r=0;r<16;++r)negm[r]=-mhat; asm volatile("":"+v"(negm)); } \
    _Pragma("unroll") for(int r=0;r<16;++r)P0[r]=__builtin_amdgcn_exp2f(P0[r]); }while(0)
  #define RESC() do{ if(resc){ asm volatile("s_waitcnt lgkmcnt(0)":::"memory"); \
      _Pragma("unroll") for(int d_=0;d_<2;++d_) _Pragma("unroll") for(int r=0;r<16;++r)o[d_][r]*=wsf[crow(r,hi)]; } }while(0)
  f32x16 pA0,pA1,pB0,pB1;
  int sl_prev=0,sl_cur=0,sl_next=SLOTB;
  #define ROT() do{sl_prev=sl_cur;sl_cur=sl_next;sl_next=(sl_next==(NSLOT-1)*SLOTB)?0:sl_next+SLOTB;}while(0)
  DMA_K(2,2*SLOTB);
  WAIT_BAR(3);
  qkt(pA0,pA1,Kbase,qr,negm,r32,hi);{const bf16x8 ba0_=BLD(0,0),ba1_=BLD(0,1);pA0=__builtin_amdgcn_mfma_f32_32x32x16_bf16(ba0_,ones,pA0,0,0,0);pA1=__builtin_amdgcn_mfma_f32_32x32x16_bf16(ba1_,ones,pA1,0,0,0);}asm volatile("s_nop 15\n\ts_nop 7":"+v"(pA0),"+v"(pA1));CMASK(pA0,pA1,0);
  START(pA0,pA1);
  _Pragma("unroll") for(int r=0;r<16;++r)pA1[r]=__builtin_amdgcn_exp2f(pA1[r]);
  WAIT_BAR(0);
  DMA_K(3,0);DMA_V(1,SLOTB);
  ROT();
  kload8(kf,kp0+sl_cur);
  WAIT_BAR(2);
  s16x4 vlo[8],vhi[8]; u32x4 pw0,pw1,pw2,pw3;
  #define PKW(P,B) cvtpk_s(P[B],P[B+1])
  #define PAF(k) __builtin_bit_cast(bf16x8,pw##k)
  #define VFR(i) (bf16x8){vlo[i][0],vlo[i][1],vlo[i][2],vlo[i][3],vhi[i][0],vhi[i][1],vhi[i][2],vhi[i][3]}
  #define PIN(x) asm volatile("":"+v"(x))
  #define MX3(a,b,c) __builtin_fmaxf(__builtin_fmaxf((a),(b)),(c))
  #define GAPA(MF,A0,A1,A2,A3,W0,W1,PW) do{ MF; sacc+=A0; sacc+=A1; sacc+=A2; sacc+=A3; PIN(sacc); W0; W1; PIN(PW); SBAR(); }while(0)
  #define EX(v) __builtin_amdgcn_exp2f(v)
  #define GAPB(MF,X,B) do{ MF; X[B]=EX(X[B]); X[B+1]=EX(X[B+1]); X[B+2]=EX(X[B+2]); X[B+3]=EX(X[B+3]); PIN(X); SBAR(); }while(0)
  #define VRD(i) do{ vlo[i]=vtr(vp_+(((i)>>2)*4096+((i)&3)*1024)); vhi[i]=vtr(vp_+(((i)>>2)*4096+((i)&3)*1024+512)); }while(0)
  #define KRD(G,j) do{ if(G){ kload2(kf,kp0+sl_next,j); SBAR(); } }while(0)
  #define STEP(C0,C1,P0,P1,t,GK,GV,GL) do{ SBAR(); \
    const lds_cptr vp_=vp0+sl_prev; const bf16x8 ba0_=BLD(t,0),ba1_=BLD(t,1); \
    VRD(0); SBAR(); float sacc=(P0[0]+P0[1]); \
    GAPA(C0=__builtin_amdgcn_mfma_f32_32x32x16_bf16(kf[0],qr[0],negm,0,0,0), P0[2],P0[3],P0[4],P0[5],     pw0[0]=PKW(P0,0), pw0[1]=PKW(P0,2), pw0); \
    VRD(4); SBAR(); GAPA(C1=__builtin_amdgcn_mfma_f32_32x32x16_bf16(kf[1],qr[0],negm,0,0,0), P0[6],P0[7],P0[8],P0[9],     pw0[2]=PKW(P0,4), pw0[3]=PKW(P0,6), pw0); \
    VRD(1); SBAR(); GAPA(C0=__builtin_amdgcn_mfma_f32_32x32x16_bf16(kf[2],qr[1],C0,0,0,0),   P0[10],P0[11],P0[12],P0[13], pw1[0]=PKW(P0,8), pw1[1]=PKW(P0,10), pw1); \
    VRD(5); SBAR(); GAPA(C1=__builtin_amdgcn_mfma_f32_32x32x16_bf16(kf[3],qr[1],C1,0,0,0),   P0[14],P0[15],P1[0],P1[1],   pw1[2]=PKW(P0,12),pw1[3]=PKW(P0,14), pw1); \
    VRD(2); SBAR(); GAPA(C0=__builtin_amdgcn_mfma_f32_32x32x16_bf16(kf[4],qr[2],C0,0,0,0),   P1[2],P1[3],P1[4],P1[5],     pw2[0]=PKW(P1,0), pw2[1]=PKW(P1,2), pw2); \
    VRD(6); SBAR(); GAPA(C1=__builtin_amdgcn_mfma_f32_32x32x16_bf16(kf[5],qr[2],C1,0,0,0),   P1[6],P1[7],P1[8],P1[9],     pw2[2]=PKW(P1,4), pw2[3]=PKW(P1,6), pw2); \
    VRD(3); SBAR(); GAPA(C0=__builtin_amdgcn_mfma_f32_32x32x16_bf16(kf[6],qr[3],C0,0,0,0),   P1[10],P1[11],P1[12],P1[13], pw3[0]=PKW(P1,8), pw3[1]=PKW(P1,10), pw3); \
    VRD(7); SBAR(); GAPA(C1=__builtin_amdgcn_mfma_f32_32x32x16_bf16(kf[7],qr[3],C1,0,0,0),   P1[14],P1[15],0.f,0.f,       pw3[2]=PKW(P1,12),pw3[3]=PKW(P1,14), pw3); \
    C0=__builtin_amdgcn_mfma_f32_32x32x16_bf16(ba0_,ones,C0,0,0,0); C1=__builtin_amdgcn_mfma_f32_32x32x16_bf16(ba1_,ones,C1,0,0,0); SBAR(); \
    l_reg+=sacc; \
    if(GK){DMA_K((t)+3,sl_cur);} if(GV){DMA_V((t)+1,sl_next);} \
    CMASK(C0,C1,t); \
    { float a=MX3(C0[0],C0[1],C1[0]),b=MX3(C0[2],C0[3],C1[1]); a=MX3(a,C1[2],C1[3]); \
      _Pragma("unroll") for(int r=4;r<16;r+=4){a=MX3(a,C0[r],C0[r+1]);b=MX3(b,C0[r+2],C0[r+3]);a=MX3(a,C1[r],C1[r+1]);b=MX3(b,C1[r+2],C1[r+3]);} \
      float rm=__builtin_fmaxf(a,b); { auto rr=__builtin_amdgcn_permlane32_swap(__float_as_uint(rm),__float_as_uint(rm),false,false); rm=__builtin_fmaxf(__uint_as_float(rr[0]),__uint_as_float(rr[1])); } \
      resc=false; \
      if(__builtin_expect(__any(rm>(float)THRL),0)){ const float dl=__builtin_fmaxf(rm,0.f); mhat+=dl; \
        _Pragma("unroll") for(int r=0;r<16;++r){C0[r]-=dl;C1[r]-=dl;} \
        _Pragma("unroll") for(int r=0;r<16;++r)negm[r]=-mhat; asm volatile("":"+v"(negm)); \
        const float f=__builtin_amdgcn_exp2f(-dl); l_reg*=f; if(hi==0)wsf[r32]=f; resc=true; } } \
    SBAR(); \
    GAPB(o[0]=__builtin_amdgcn_mfma_f32_32x32x16_bf16(PAF(0),VFR(0),o[0],0,0,0), C0,0); \
    GAPB(o[1]=__builtin_amdgcn_mfma_f32_32x32x16_bf16(PAF(0),VFR(4),o[1],0,0,0), C0,4); \
    KRD(GL,0); GAPB(o[0]=__builtin_amdgcn_mfma_f32_32x32x16_bf16(PAF(1),VFR(1),o[0],0,0,0), C0,8); \
    KRD(GL,1); GAPB(o[1]=__builtin_amdgcn_mfma_f32_32x32x16_bf16(PAF(1),VFR(5),o[1],0,0,0), C0,12); \
    KRD(GL,2); GAPB(o[0]=__builtin_amdgcn_mfma_f32_32x32x16_bf16(PAF(2),VFR(2),o[0],0,0,0), C1,0); \
    KRD(GL,3); GAPB(o[1]=__builtin_amdgcn_mfma_f32_32x32x16_bf16(PAF(2),VFR(6),o[1],0,0,0), C1,4); \
    GAPB(o[0]=__builtin_amdgcn_mfma_f32_32x32x16_bf16(PAF(3),VFR(3),o[0],0,0,0), C1,8); \
    GAPB(o[1]=__builtin_amdgcn_mfma_f32_32x32x16_bf16(PAF(3),VFR(7),o[1],0,0,0), C1,12); \
    }while(0)
  int t=1;
  #undef CMASK
  #define CMASK(P0,P1,t) do{}while(0)
  for(;t+5<NT;t+=2){
    STEP(pB0,pB1,pA0,pA1,t,true,true,true);     WAIT_BAR(2); RESC(); ROT();
    STEP(pA0,pA1,pB0,pB1,t+1,true,true,true);   WAIT_BAR(2); RESC(); ROT();
  }
  #undef CMASK
  #define CMASK(P0,P1,t) do{int jb_=(t)-(NT-4); if(jb_>=0)cmask(P0,P1,jb_,qrel,hi);}while(0)
  #define ENDW(tt) do{ if((tt)+3<NT){WAIT_BAR(2);} else if((tt)+2<NT){WAIT_BAR(1);} else {WAIT_BAR(0);} }while(0)
  for(;t+1<NT;t+=2){
    STEP(pB0,pB1,pA0,pA1,t,(t+3<NT),(t+1<NT),(t+1<NT));       ENDW(t);   RESC(); ROT();
    STEP(pA0,pA1,pB0,pB1,t+1,(t+4<NT),(t+2<NT),(t+2<NT));     ENDW(t+1); RESC(); ROT();
  }
  STEP(pB0,pB1,pA0,pA1,NT-1,false,false,false); RESC();
  { float sacc=pB0[0]+pB0[1]; _Pragma("unroll") for(int r=2;r<16;++r)sacc+=pB0[r]; _Pragma("unroll") for(int r=0;r<16;++r)sacc+=pB1[r]; l_reg+=sacc;
    pw0=(u32x4){PKW(pB0,0),PKW(pB0,2),PKW(pB0,4),PKW(pB0,6)};pw1=(u32x4){PKW(pB0,8),PKW(pB0,10),PKW(pB0,12),PKW(pB0,14)};pw2=(u32x4){PKW(pB1,0),PKW(pB1,2),PKW(pB1,4),PKW(pB1,6)};pw3=(u32x4){PKW(pB1,8),PKW(pB1,10),PKW(pB1,12),PKW(pB1,14)};
    SBAR(); pv(o,(int)(lds0+LDS_V)+((lane>>4)&1)*32+(lane&3)*8+(4*hi+((lane&15)>>2))*64+sl_cur,PAF(0),PAF(1),PAF(2),PAF(3)); }
  #undef PKW
  #undef PAF
  #undef VFR
  #undef PIN
  #undef MX3
  #undef GAPA
  #undef GAPB
  #undef EX
  #undef VRD
  #undef KRD
  #undef STEP
  #undef ENDW
  {auto rr=__builtin_amdgcn_permlane32_swap(__float_as_uint(l_reg),__float_as_uint(l_reg),false,false);l_reg=__uint_as_float(rr[0])+__uint_as_float(rr[1]);}
  if(hi==0)wsf[32+r32]=l_reg;asm volatile("s_waitcnt lgkmcnt(0)":::"memory");
  float rli[16];
  #pragma unroll
  for(int r=0;r<16;++r)rli[r]=__builtin_amdgcn_rcpf(wsf[32+crow(r,hi)]);
  bf16*Ow=O+(rowbase+q0+wid*QBLK)*DM+h*D;
  { bf16*stg=(bf16*)(shm+LDS_OST)+wid*2048;
    #pragma unroll
    for(int r=0;r<16;++r){const int orow=crow(r,hi);
      #pragma unroll
      for(int d0=0;d0<2;++d0)stg[orow*64+d0*32+r32]=__float2bfloat16(o[d0][r]*rli[r]);}
    asm volatile("s_waitcnt lgkmcnt(0)":::"memory");
    #pragma unroll
    for(int i=0;i<4;++i){const int row=i*8+(lane>>3),ch=lane&7; const u32x4 v=*(const u32x4*)(stg+row*64+ch*8); ATTN_STORE16(Ow+(long)row*DM+ch*8,v);} }
  asm volatile("s_waitcnt lgkmcnt(0)\n\ts_barrier":::"memory");
  #undef DMA_K
  #undef BLD
  #undef DMA_V
  #undef CMASK
  #undef START
  #undef RESC
  #undef ROT
}
constexpr int ATTN_LDS_BYTES=LDS_BYTES;
struct AttnTensors { const bf16* Q; const bf16* K; const bf16* V; bf16* O; const float* CL; };
struct AttnUnit { int bh; int qb; };
struct StaticOrder {
  int vcu;
  __device__ __forceinline__ explicit StaticOrder(int grid,int block):vcu((block%8)*(grid/8)+block/8){}
  __device__ __forceinline__ bool next(int i,AttnUnit&u)const{ if(i>=8)return false; const int s=vcu&7,j=i&3; u.bh=(vcu>>3)+32*(i>>2); u.qb=(j==0)?s:(j==1)?15-s:(j==2)?16+s:31-s; return true; }
  __device__ __forceinline__ void a_ready(const AttnUnit&)const{}
  __device__ __forceinline__ void done(const AttnUnit&)const{}
};
template<class Sched,int THRL=8> __device__ __forceinline__ void attn_phase(char*lds,const AttnTensors&T,const Sched&S){
  AttnUnit u;
  for(int i=0;S.next(i,u);++i){ S.a_ready(u); attn_unit<THRL>(u.bh/NHEAD,u.bh%NHEAD,u.qb,T.Q,T.K,T.V,T.O,T.CL+(long)u.bh*SEQ,lds); S.done(u); }
}
#undef SBAR
#undef WAIT_BAR
}
namespace cg = cooperative_groups;
#define LAS __attribute__((address_space(3)))
typedef unsigned short bf16;
typedef unsigned v4u __attribute__((ext_vector_type(4)));
typedef unsigned v2u __attribute__((ext_vector_type(2)));
typedef float f32x4 __attribute__((ext_vector_type(4)));
typedef float f32x16 __attribute__((ext_vector_type(16)));
typedef short bf16x8 __attribute__((ext_vector_type(8)));
typedef short s16x4 __attribute__((ext_vector_type(4)));

constexpr int NWAVES = 8, NTHR = 512;
constexpr int BATCH = 4, SEQ = 8192, D = 1024, M = BATCH * SEQ;
constexpr int DIN = 9232, DFF = 2816, NUP = 2 * DFF;
constexpr float EPS = 1e-6f, LOG2E = 1.4426950408889634f;
constexpr size_t MiB = 1u << 20;
constexpr size_t WS_SS1 = 0, WS_SS2 = 128 * 1024, WS_LBV = 256 * 1024, WS_BAR = 512 * 1024, BAR_BYTES = 16384;
constexpr size_t WS_FLOG = 1 * MiB, WS_CL = 3 * MiB, WS_DK = 5 * MiB;
constexpr size_t WS_WIN = 8 * MiB, WS_WA = 26 * MiB, WS_WB = 28 * MiB, WS_WO = 30 * MiB, WS_WUP = 32 * MiB, WS_WDN = 43 * MiB;
constexpr size_t WS_SLOT0 = 52 * MiB, SLOT = 64 * MiB;
constexpr size_t WS_END = WS_SLOT0 + 7 * SLOT;
constexpr int RING_BYTES = 131072, HALO_OFF = RING_BYTES, MISC_OFF = RING_BYTES + 8192, LDS_BYTES = 151552, BARW_OFF = LDS_BYTES - 64;
constexpr int UP_TM = 254, UP_NM = 130;
static_assert(attn_body::ATTN_LDS_BYTES <= LDS_BYTES, "attention LDS");

#define LDS_WAIT() asm volatile("s_waitcnt lgkmcnt(0)" ::: "memory")
__device__ __forceinline__ unsigned f2bf(float f) { unsigned u = __builtin_bit_cast(unsigned, f); return (u + 0x7fffu + ((u >> 16) & 1u)) >> 16; }
__device__ __forceinline__ unsigned pk2(float lo, float hi) { return pg8::cvt_pk_bf16(lo, hi); }
__device__ __forceinline__ float bf2f(unsigned short v) { return __builtin_bit_cast(float, (unsigned)v << 16); }
__device__ __forceinline__ float bflo(unsigned w) { return __builtin_bit_cast(float, w << 16); }
__device__ __forceinline__ float bfhi(unsigned w) { return __builtin_bit_cast(float, w & 0xffff0000u); }
__device__ __forceinline__ float wave_sum(float v) {
#pragma unroll
    for (int o = 1; o < 64; o <<= 1) v += __shfl_xor(v, o);
    return v;
}
__device__ __forceinline__ float fexp(float x) { return __builtin_amdgcn_exp2f(x * LOG2E); }
__device__ __forceinline__ float flog(float x) { return __builtin_amdgcn_logf(x) * 0.6931471805599453f; }
__device__ __forceinline__ float fsigmoid(float x) { return __builtin_amdgcn_rcpf(1.0f + fexp(-x)); }
__device__ __forceinline__ int crow(int r, int hi) { return (r & 3) + 8 * (r >> 2) + 4 * hi; }

__device__ __forceinline__ void transpose_item(const float* W, int ldw, bf16* WT, int Kd, int k0, int n0, int dst_row0, LAS float* scr, int lane) {
#pragma unroll 8
    for (int i = 0; i < 32; ++i) { const int kk = 2 * i + (lane >> 5); scr[kk * 33 + (lane & 31)] = W[(size_t)(k0 + kk) * ldw + n0 + (lane & 31)]; }
    LDS_WAIT(); asm volatile("" ::: "memory");
    const int c = lane & 7;
#pragma unroll
    for (int j = 0; j < 4; ++j) { const int n = (lane >> 3) + 8 * j; const LAS float* s = scr + (8 * c) * 33 + n;
        v4u o; o.x = pk2(s[0 * 33], s[1 * 33]); o.y = pk2(s[2 * 33], s[3 * 33]); o.z = pk2(s[4 * 33], s[5 * 33]); o.w = pk2(s[6 * 33], s[7 * 33]);
        *(v4u*)(WT + (size_t)(dst_row0 + n) * Kd + k0 + 8 * c) = o; }
    LDS_WAIT(); asm volatile("" ::: "memory");
}

struct Ptrs {
    const float *x, *norm_mix, *w_in, *fbias, *lblog, *hg_norm, *w_a, *w_b, *w_o, *norm_ffn, *w_up, *conv_w, *conv_b, *w_dn, *norm_final;
    float* out; unsigned char* ws;
};

__device__ __forceinline__ void p0_prologue(LAS unsigned char* lds, const Ptrs& P, int G) {
    int tid_ = threadIdx.x; asm volatile("" : "+v"(tid_)); const int tid = tid_, lane = tid & 63, wave = tid >> 6;
    const int gw = blockIdx.x * NWAVES + wave, NGW = G * NWAVES;
    unsigned char* ws = P.ws;
    bf16* Wt_in = (bf16*)(ws + WS_WIN);
    {
        LAS float* scr = (LAS float*)(lds + wave * 16384);
        constexpr int I0 = 16 * 224, I1 = 16 * 64, I2 = 16 * 32, I5 = 16 * 176, I6 = 44 * 32;
        constexpr int NIT = I0 + I1 + 3 * I2 + I5 + I6;
        for (int it = gw; it < NIT; it += NGW) {
            int r = it;
            if (r < I0) { const int kb = r / 224, nb = r % 224; transpose_item(P.w_in, DIN, Wt_in, D, 64 * kb, 32 * nb, 32 * nb, scr, lane); continue; } r -= I0;
            if (r < I1) { const int kb = r / 64, nb = r % 64; transpose_item(P.w_in + 7184, DIN, Wt_in, D, 64 * kb, 32 * nb, 7168 + 32 * nb, scr, lane); continue; } r -= I1;
            if (r < I2) { const int kb = r / 32, nb = r % 32; transpose_item(P.w_a, D, (bf16*)(ws + WS_WA), D, 64 * kb, 32 * nb, 32 * nb, scr, lane); continue; } r -= I2;
            if (r < I2) { const int kb = r / 32, nb = r % 32; transpose_item(P.w_b, D, (bf16*)(ws + WS_WB), D, 64 * kb, 32 * nb, 32 * nb, scr, lane); continue; } r -= I2;
            if (r < I2) { const int kb = r / 32, nb = r % 32; transpose_item(P.w_o, D, (bf16*)(ws + WS_WO), D, 64 * kb, 32 * nb, 32 * nb, scr, lane); continue; } r -= I2;
            if (r < I5) { const int kb = r / 176, nb = r % 176; const int n0 = 32 * nb; const int nn = n0 < DFF ? n0 : n0 - DFF;
                const int dst = 256 * (nn / 128) + (nn % 128) + (n0 < DFF ? 0 : 128);
                transpose_item(P.w_up, NUP, (bf16*)(ws + WS_WUP), D, 64 * kb, n0, dst, scr, lane); continue; } r -= I5;
            { const int kb = r / 32, nb = r % 32; transpose_item(P.w_dn, D, (bf16*)(ws + WS_WDN), DFF, 64 * kb, 32 * nb, 32 * nb, scr, lane); }
        }
    }
    { float* ss = (float*)(ws + WS_SS1); for (int i = blockIdx.x * NTHR + tid; i < 2 * M; i += G * NTHR) ss[i] = 0.f; }
    if (blockIdx.x == 0) { float* lbv = (float*)(ws + WS_LBV); for (int k = tid; k < 1024; k += NTHR) lbv[k] = fsigmoid(P.lblog[k] - P.lblog[1024 + k]); }
    __syncthreads();
    LAS float* wf = (LAS float*)lds;
    for (int i = tid; i < 1024 * 16; i += NTHR) wf[i] = P.w_in[(size_t)(i >> 4) * DIN + 7168 + (i & 15)];
    __syncthreads();
    f32x4 gm[4];
#pragma unroll
    for (int j = 0; j < 4; ++j) gm[j] = ((const f32x4*)P.norm_mix)[lane + 64 * j];
    const float fb = P.fbias[(lane >> 2) & 15];
    bf16* XN = (bf16*)(ws + WS_SLOT0);
    float* FLOG = (float*)(ws + WS_FLOG);
    for (int m = gw; m < M; m += NGW) {
        const f32x4* xr = (const f32x4*)(P.x + (size_t)m * D) + lane;
        f32x4 v[4]; float s2 = 0.f;
#pragma unroll
        for (int j = 0; j < 4; ++j) { v[j] = xr[64 * j]; s2 += (v[j].x * v[j].x + v[j].y * v[j].y) + (v[j].z * v[j].z + v[j].w * v[j].w); }
        const float rstd = 1.0f / sqrtf(wave_sum(s2) * (1.f / D) + EPS);
        unsigned long long* o8 = (unsigned long long*)(XN + (size_t)m * D) + lane;
        float acc[16];
#pragma unroll
        for (int i = 0; i < 16; ++i) acc[i] = 0.f;
#pragma unroll
        for (int j = 0; j < 4; ++j) {
            v[j] = v[j] * rstd * gm[j];
            o8[64 * j] = (unsigned long long)pk2(v[j].x, v[j].y) | ((unsigned long long)pk2(v[j].z, v[j].w) << 32);
#pragma unroll
            for (int e = 0; e < 4; ++e) { const LAS f32x4* wr = (const LAS f32x4*)(wf + (256 * j + 4 * lane + e) * 16); const float xv = v[j][e];
#pragma unroll
                for (int q = 0; q < 4; ++q) { const f32x4 w = wr[q]; acc[4 * q] += xv * w.x; acc[4 * q + 1] += xv * w.y; acc[4 * q + 2] += xv * w.z; acc[4 * q + 3] += xv * w.w; } }
        }
        float a8[8], a4[4], a2[2], a1;
        { const bool up = lane & 32;
#pragma unroll
          for (int i = 0; i < 8; ++i) { const float mine = up ? acc[i + 8] : acc[i], oth = up ? acc[i] : acc[i + 8]; a8[i] = mine + __shfl_xor(oth, 32); } }
        { const bool up = lane & 16;
#pragma unroll
          for (int i = 0; i < 4; ++i) { const float mine = up ? a8[i + 4] : a8[i], oth = up ? a8[i] : a8[i + 4]; a4[i] = mine + __shfl_xor(oth, 16); } }
        { const bool up = lane & 8;
#pragma unroll
          for (int i = 0; i < 2; ++i) { const float mine = up ? a4[i + 2] : a4[i], oth = up ? a4[i] : a4[i + 2]; a2[i] = mine + __shfl_xor(oth, 8); } }
        { const bool up = lane & 4; const float mine = up ? a2[1] : a2[0], oth = up ? a2[0] : a2[1]; a1 = mine + __shfl_xor(oth, 4); }
        a1 += __shfl_xor(a1, 2); a1 += __shfl_xor(a1, 1);
        const float z = a1 + fb;
        const float ls = fminf(z, 0.f) - log1pf(expf(-fabsf(z)));
        if ((lane & 3) == 0) FLOG[(size_t)m * 16 + (lane >> 2)] = ls;
    }
}

__device__ __forceinline__ void p1_cscan(LAS unsigned char* lds, const Ptrs& P) {
    if (blockIdx.x >= 64) return;
    int tid_ = threadIdx.x; asm volatile("" : "+v"(tid_)); const int tid = tid_, lane = tid & 63, wave = tid >> 6;
    const int s = blockIdx.x, b = s >> 4, h = s & 15;
    const float* fl = (const float*)(P.ws + WS_FLOG) + (size_t)b * SEQ * 16 + h;
    float v[16]; float run = 0.f;
#pragma unroll
    for (int j = 0; j < 16; ++j) { run += fl[(size_t)(16 * tid + j) * 16]; v[j] = run; }
    float tot = run;
#pragma unroll
    for (int o = 1; o < 64; o <<= 1) { const float t = __shfl_up(tot, o); if (lane >= o) tot += t; }
    LAS float* wsum = (LAS float*)(lds + MISC_OFF);
    if (lane == 63) wsum[wave] = tot;
    __syncthreads();
    float base = 0.f;
#pragma unroll
    for (int w = 0; w < 8; ++w) if (w < wave) base += wsum[w];
    const float pre = base + tot - run;
    float* cl = (float*)(P.ws + WS_CL) + (size_t)s * SEQ + 16 * tid;
#pragma unroll
    for (int j = 0; j < 16; ++j) cl[j] = (pre + v[j]) * LOG2E;
    __syncthreads();
}

using pg8::Unit; using pg8::HALF; using pg8::BM;
struct EpiProj {
    static constexpr bool PERM = true, AFTER_DRAIN = false;
    bf16 *o0, *o1, *o2, *o3; int m0, m1, m2, m3; float scale0; const float* lbv;
    __device__ __forceinline__ void operator()(const f32x4 (&acc)[2][2][4][2], const Unit& u, int wr, int wc, int fr, int fq) const {
        const int colt = u.pn * BM, seg = colt >> 10, colin = colt & 1023;
        bf16* base = (bf16*)((uintptr_t)(seg == 0) * (uintptr_t)o0 + (uintptr_t)(seg == 1) * (uintptr_t)o1 + (uintptr_t)(seg == 2) * (uintptr_t)o2 + (uintptr_t)(seg == 3) * (uintptr_t)o3);
        const int mode = (seg == 0) * m0 + (seg == 1) * m1 + (seg == 2) * m2 + (seg == 3) * m3;
        const float sc = seg == 0 ? scale0 : 1.f;
        const int row0 = u.pm * BM + wr * 64 + fr, col0 = colin + wc * 32 + 8 * fq;
#pragma unroll
        for (int ai = 0; ai < 2; ++ai)
#pragma unroll
            for (int m = 0; m < 4; ++m) { bf16* rowp = base + (size_t)(row0 + ai * HALF + m * 16) * D + col0;
#pragma unroll
                for (int bj = 0; bj < 2; ++bj) { const f32x4 a0 = acc[ai][bj][m][0], a1 = acc[ai][bj][m][1];
                    float r[8] = {a0[0], a0[1], a0[2], a0[3], a1[0], a1[1], a1[2], a1[3]};
                    if (mode == 0) {
#pragma unroll
                        for (int q = 0; q < 8; ++q) r[q] *= sc;
                    } else if (mode == 1) {
#pragma unroll
                        for (int q = 0; q < 8; ++q) r[q] = r[q] * fsigmoid(r[q]);
                    } else {
                        const f32x4 l0 = *(const f32x4*)(lbv + col0 + bj * HALF), l1 = *(const f32x4*)(lbv + col0 + bj * HALF + 4);
                        const float l8[8] = {l0[0], l0[1], l0[2], l0[3], l1[0], l1[1], l1[2], l1[3]};
#pragma unroll
                        for (int q = 0; q < 8; ++q) r[q] = flog(l8[q] + (1.f - l8[q]) * fsigmoid(r[q]));
                    }
                    v4u w; w.x = pk2(r[0], r[1]); w.y = pk2(r[2], r[3]); w.z = pk2(r[4], r[5]); w.w = pk2(r[6], r[7]);
                    *(v4u*)(rowp + bj * HALF) = w; } }
    }
};
struct EpiGate {
    static constexpr bool PERM = true, AFTER_DRAIN = false;
    const bf16* gate; const bf16* add; bf16* out;
    __device__ __forceinline__ void operator()(const f32x4 (&acc)[2][2][4][2], const Unit& u, int wr, int wc, int fr, int fq) const {
        const int row0 = u.pm * BM + wr * 64 + fr, col0 = u.pn * BM + wc * 32 + 8 * fq;
#pragma unroll
        for (int ai = 0; ai < 2; ++ai)
#pragma unroll
            for (int m = 0; m < 4; ++m) { const size_t off = (size_t)(row0 + ai * HALF + m * 16) * D + col0;
#pragma unroll
                for (int bj = 0; bj < 2; ++bj) {
                    const v4u g = *(const v4u*)(gate + off + bj * HALF);
                    v4u a = (v4u){0u, 0u, 0u, 0u}; if (add) a = *(const v4u*)(add + off + bj * HALF);
                    const f32x4 v0 = acc[ai][bj][m][0], v1 = acc[ai][bj][m][1];
                    float r[8];
                    r[0] = bflo(a.x) + fsigmoid(bflo(g.x)) * v0[0]; r[1] = bfhi(a.x) + fsigmoid(bfhi(g.x)) * v0[1];
                    r[2] = bflo(a.y) + fsigmoid(bflo(g.y)) * v0[2]; r[3] = bfhi(a.y) + fsigmoid(bfhi(g.y)) * v0[3];
                    r[4] = bflo(a.z) + fsigmoid(bflo(g.z)) * v1[0]; r[5] = bfhi(a.z) + fsigmoid(bfhi(g.z)) * v1[1];
                    r[6] = bflo(a.w) + fsigmoid(bflo(g.w)) * v1[2]; r[7] = bfhi(a.w) + fsigmoid(bfhi(g.w)) * v1[3];
                    v4u w; w.x = pk2(r[0], r[1]); w.y = pk2(r[2], r[3]); w.z = pk2(r[4], r[5]); w.w = pk2(r[6], r[7]);
                    *(v4u*)(out + off + bj * HALF) = w; } }
    }
};
struct EpiRes {
    static constexpr bool PERM = false, AFTER_DRAIN = false;
    const float* base; float* out; bf16* xh; const float* gcol; float* ss;
    __device__ __forceinline__ void operator()(const f32x4 (&acc)[2][2][4][2], const Unit& u, int wr, int wc, int fr, int fq) const {
        const int col0 = u.pn * BM + wc * 32 + 4 * fq;
        f32x4 gv[2][2];
#pragma unroll
        for (int bj = 0; bj < 2; ++bj)
#pragma unroll
            for (int n = 0; n < 2; ++n) gv[bj][n] = xh ? *(const f32x4*)(gcol + col0 + bj * HALF + n * 16) : (f32x4){0.f, 0.f, 0.f, 0.f};
#pragma unroll
        for (int ai = 0; ai < 2; ++ai)
#pragma unroll
            for (int m = 0; m < 4; ++m) { const int row = u.pm * BM + ai * HALF + wr * 64 + m * 16 + fr; const size_t off = (size_t)row * D + col0; float s = 0.f;
#pragma unroll
                for (int bj = 0; bj < 2; ++bj)
#pragma unroll
                    for (int n = 0; n < 2; ++n) { const f32x4 h = *(const f32x4*)(base + off + bj * HALF + n * 16) + acc[ai][bj][m][n];
                        *(f32x4*)(out + off + bj * HALF + n * 16) = h; s += (h[0] * h[0] + h[1] * h[1]) + (h[2] * h[2] + h[3] * h[3]);
                        if (xh) { const f32x4 g = h * gv[bj][n]; v2u w; w.x = pk2(g[0], g[1]); w.y = pk2(g[2], g[3]); *(v2u*)(xh + off + bj * HALF + n * 16) = w; } }
                s += __shfl_xor(s, 16); s += __shfl_xor(s, 32);
                if (fq == 0) atomicAdd(ss + row, s);
                asm volatile("" ::: "memory"); }
    }
};
#define DPP_ROR1 0x121
#define DPP_ROR2 0x122
#define DPP_SHR1 0x111
#define DPP_SHR2 0x112
template <int CTRL> __device__ __forceinline__ float dppf(float old, float src) {
    return __builtin_bit_cast(float, __builtin_amdgcn_update_dpp(__builtin_bit_cast(int, old), __builtin_bit_cast(int, src), CTRL, 0xf, 0xf, false));
}
struct EpiConvGlu {
    static constexpr bool PERM = true, AFTER_DRAIN = false;
    bf16* hm; const float* ss1; const float* conv_w; const float* conv_b; LAS unsigned char* halo;
    __device__ __forceinline__ void operator()(const f32x4 (&acc)[2][2][4][2], const Unit& u, int wr, int wc, int fr, int fq) const {
        LAS f32x4* H = (LAS f32x4*)halo;
        const int grow0 = UP_TM * u.pm - 2 + wr * 64 + fr;
        float rs[2][4];
#pragma unroll
        for (int ai = 0; ai < 2; ++ai)
#pragma unroll
            for (int m = 0; m < 4; ++m) { int g = grow0 + ai * HALF + m * 16; g = g < 0 ? 0 : (g > M - 1 ? M - 1 : g); rs[ai][m] = 1.0f / sqrtf(ss1[g] * (1.f / D) + EPS); }
        if (fr >= 14) {
#pragma unroll
            for (int ai = 0; ai < 2; ++ai)
#pragma unroll
                for (int bj = 0; bj < 2; ++bj)
#pragma unroll
                    for (int n = 0; n < 2; ++n) H[((((ai * 2 + wr) * 2 + (fr - 14)) * 4 + wc) * 4 + fq) * 4 + bj * 2 + n] = acc[ai][bj][3][n] * rs[ai][3];
        }
        asm volatile("s_waitcnt lgkmcnt(0)\n\ts_barrier" ::: "memory");
        const int gc0 = u.pn * 128 + wc * 32 + 8 * fq;
#pragma unroll
        for (int n = 0; n < 2; ++n) {
            const int gc = gc0 + 4 * n;
            f32x4 w0[2], w1[2], w2[2], cb[2];
#pragma unroll
            for (int bj = 0; bj < 2; ++bj) { const int c = gc + bj * DFF; w0[bj] = *(const f32x4*)(conv_w + c); w1[bj] = *(const f32x4*)(conv_w + NUP + c); w2[bj] = *(const f32x4*)(conv_w + 2 * NUP + c); cb[bj] = *(const f32x4*)(conv_b + c); }
#pragma unroll
            for (int ai = 0; ai < 2; ++ai) {
                const int blk = ai * 2 + wr;
                f32x4 o1[2], o2[2];
#pragma unroll
                for (int bj = 0; bj < 2; ++bj) {
                    if (blk > 0) { o1[bj] = H[(((((blk - 1) * 2 + 1) * 4 + wc) * 4 + fq) * 4) + bj * 2 + n]; o2[bj] = H[(((((blk - 1) * 2 + (fr & 1)) * 4 + wc) * 4 + fq) * 4) + bj * 2 + n]; }
                    else { o1[bj] = (f32x4){0.f, 0.f, 0.f, 0.f}; o2[bj] = (f32x4){0.f, 0.f, 0.f, 0.f}; }
                }
                f32x4 prev[2];
#pragma unroll
                for (int m = 0; m < 4; ++m) {
                    const int i = ai * HALF + wr * 64 + m * 16 + fr, grow = UP_TM * u.pm - 2 + i, tt = grow & (SEQ - 1);
                    f32x4 y[2];
#pragma unroll
                    for (int bj = 0; bj < 2; ++bj) {
                        const f32x4 x = acc[ai][bj][m][n] * rs[ai][m];
#pragma unroll
                        for (int e = 0; e < 4; ++e) {
                            float p1, p2;
                            if (m == 0) { p1 = dppf<DPP_SHR1>(o1[bj][e], x[e]); p2 = dppf<DPP_SHR2>(o2[bj][e], x[e]); }
                            else { const float r1 = dppf<DPP_ROR1>(0.f, prev[bj][e]), r2 = dppf<DPP_ROR2>(0.f, prev[bj][e]); p1 = dppf<DPP_SHR1>(r1, x[e]); p2 = dppf<DPP_SHR2>(r2, x[e]); }
                            if (tt == 0) p1 = 0.f;
                            if (tt < 2) p2 = 0.f;
                            y[bj][e] = cb[bj][e] + w2[bj][e] * x[e] + w1[bj][e] * p1 + w0[bj][e] * p2;
                        }
                        prev[bj] = x;
                    }
                    const pg8::f32x2 ga = pg8::gelu_pk((pg8::f32x2){y[0][0], y[0][1]}), gb = pg8::gelu_pk((pg8::f32x2){y[0][2], y[0][3]});
                    v2u w; w.x = pk2(ga.x * y[1][0], ga.y * y[1][1]); w.y = pk2(gb.x * y[1][2], gb.y * y[1][3]);
                    if (i >= 2 && grow < M) *(v2u*)(hm + (size_t)grow * DFF + gc) = w;
                }
            }
        }
    }
};

__device__ __forceinline__ void hgrn_load_cumsum(const bf16* pf, float (&lf)[16], float (&bl)[16]) {
#pragma unroll
    for (int j = 0; j < 16; ++j) lf[j] = bf2f(pf[(size_t)j * D]);
    float run = 0.f;
#pragma unroll
    for (int j = 0; j < 16; ++j) { run += lf[j]; bl[j] = run; }
}
__device__ __forceinline__ void hgrn_vt_store(const bf16* pv, LAS bf16* VT, int k, int part) {
    unsigned short vv[16];
#pragma unroll
    for (int j = 0; j < 16; ++j) vv[j] = pv[(size_t)j * D];
    v4u w0, w1;
    w0.x = vv[0] | ((unsigned)vv[1] << 16); w0.y = vv[2] | ((unsigned)vv[3] << 16); w0.z = vv[4] | ((unsigned)vv[5] << 16); w0.w = vv[6] | ((unsigned)vv[7] << 16);
    w1.x = vv[8] | ((unsigned)vv[9] << 16); w1.y = vv[10] | ((unsigned)vv[11] << 16); w1.z = vv[12] | ((unsigned)vv[13] << 16); w1.w = vv[14] | ((unsigned)vv[15] << 16);
    *(LAS v4u*)(VT + k * 72 + 16 * part) = w0; *(LAS v4u*)(VT + k * 72 + 16 * part + 8) = w1;
}
__device__ __forceinline__ void hgrn_pass_a(LAS unsigned char* lds, const bf16* HLF, const bf16* HI, bf16* LS, float* DK, int G) {
    int tid_ = threadIdx.x; asm volatile("" : "+v"(tid_)); const int tid = tid_, lane = tid & 63, wave = tid >> 6, k = tid & 127, part = tid >> 7;
    LAS bf16* KT = (LAS bf16*)lds;
    LAS bf16* VT = (LAS bf16*)(lds + 18432);
    LAS float* SM = (LAS float*)(lds + 36864);
    for (int u = blockIdx.x; u < 4096; u += G) {
        const int bh = u >> 7, c = u & 127, b = bh >> 3, h = bh & 7;
        const size_t rowbase = (size_t)b * SEQ + c * 64 + 16 * part;
        float lf[16], bl[16];
        hgrn_load_cumsum(HLF + rowbase * D + h * 128 + k, lf, bl);
        SM[part * 128 + k] = bl[15];
        hgrn_vt_store(HI + rowbase * D + h * 128 + k, VT, k, part);
        __syncthreads();
        const float s0 = SM[k], s1 = SM[128 + k], s2 = SM[256 + k], s3 = SM[384 + k];
        const float tot = (s0 + s1) + (s2 + s3);
        const float pre = (part > 0 ? s0 : 0.f) + (part > 1 ? s1 : 0.f) + (part > 2 ? s2 : 0.f);
        unsigned pw[8];
#pragma unroll
        for (int j = 0; j < 16; j += 2) {
            const float k0 = (1.f - fexp(lf[j])) * fexp(tot - (pre + bl[j])), k1 = (1.f - fexp(lf[j + 1])) * fexp(tot - (pre + bl[j + 1]));
            pw[j >> 1] = pk2(k0, k1);
        }
        *(LAS v4u*)(KT + k * 72 + 16 * part) = (v4u){pw[0], pw[1], pw[2], pw[3]}; *(LAS v4u*)(KT + k * 72 + 16 * part + 8) = (v4u){pw[4], pw[5], pw[6], pw[7]};
        if (part == 0) DK[(size_t)u * 128 + k] = fexp(tot);
        __syncthreads();
        const int r = lane & 31, hh = lane >> 5, vi = wave >> 1;
#pragma unroll
        for (int q = 0; q < 2; ++q) {
            const int kj = 2 * (wave & 1) + q; f32x16 acc = {};
#pragma unroll
            for (int ks = 0; ks < 4; ++ks) {
                const bf16x8 a = *(const LAS bf16x8*)(VT + (32 * vi + r) * 72 + 16 * ks + 8 * hh);
                const bf16x8 bb = *(const LAS bf16x8*)(KT + (32 * kj + r) * 72 + 16 * ks + 8 * hh);
                acc = __builtin_amdgcn_mfma_f32_32x32x16_bf16(a, bb, acc, 0, 0, 0);
            }
            bf16* dst = LS + (size_t)u * 16384 + (32 * vi) * 128 + 32 * kj + r;
#pragma unroll
            for (int i = 0; i < 16; ++i) dst[crow(i, hh) * 128] = (bf16)f2bf(acc[i]);
        }
        __syncthreads();
    }
}
__device__ __forceinline__ void hgrn_pass_b(unsigned* LS32, const float* DK, int G) {
    int tid_ = threadIdx.x; asm volatile("" : "+v"(tid_)); const int gt = blockIdx.x * NTHR + tid_, NG = G * NTHR;
    for (int p = gt; p < 32 * 8192; p += NG) {
        const int bh = p >> 13, e2 = p & 8191, k = 2 * (e2 & 63);
        unsigned* ls = LS32 + (size_t)bh * 128 * 8192 + e2;
        const float* dk = DK + (size_t)bh * 128 * 128 + k;
        float s0 = 0.f, s1 = 0.f;
        for (int c0 = 0; c0 < 128; c0 += 8) {
            unsigned w[8]; float d0[8], d1[8];
#pragma unroll
            for (int i = 0; i < 8; ++i) { w[i] = ls[(size_t)(c0 + i) * 8192]; const float2 d = *(const float2*)(dk + (size_t)(c0 + i) * 128); d0[i] = d.x; d1[i] = d.y; }
#pragma unroll
            for (int i = 0; i < 8; ++i) { ls[(size_t)(c0 + i) * 8192] = pk2(s0, s1); s0 = d0[i] * s0 + bflo(w[i]); s1 = d1[i] * s1 + bfhi(w[i]); }
        }
    }
}
__device__ __forceinline__ void hgrn_pass_c(LAS unsigned char* lds, bf16* HQ, const bf16* HLF, const bf16* HI, const bf16* HG, const bf16* LS, const float* gnorm, int G) {
    int tid_ = threadIdx.x; asm volatile("" : "+v"(tid_)); const int tid = tid_, lane = tid & 63, wave = tid >> 6, k = tid & 127, part = tid >> 7;
    LAS bf16* QT = (LAS bf16*)lds;
    LAS bf16* KT2 = (LAS bf16*)(lds + 17408);
    LAS bf16* VT = (LAS bf16*)(lds + 34816);
    LAS float* OL = (LAS float*)(lds + 53248);
    LAS float* SM = (LAS float*)(lds + 87040);
    for (int u = blockIdx.x; u < 4096; u += G) {
        const int bh = u >> 7, c = u & 127, b = bh >> 3, h = bh & 7;
        const size_t row0 = (size_t)b * SEQ + c * 64, rowbase = row0 + 16 * part;
        float lf[16], bl[16];
        hgrn_load_cumsum(HLF + rowbase * D + h * 128 + k, lf, bl);
        SM[part * 128 + k] = bl[15];
        hgrn_vt_store(HI + rowbase * D + h * 128 + k, VT, k, part);
        float qs[16];
        { const bf16* pq = HQ + rowbase * D + h * 128 + k;
#pragma unroll
          for (int j = 0; j < 16; ++j) qs[j] = bf2f(pq[(size_t)j * D]); }
        __syncthreads();
        const float s0 = SM[k], s1 = SM[128 + k], s2 = SM[256 + k];
        const float pre = (part > 0 ? s0 : 0.f) + (part > 1 ? s1 : 0.f) + (part > 2 ? s2 : 0.f);
#pragma unroll
        for (int j = 0; j < 16; ++j) {
            const float bb = pre + bl[j];
            QT[(16 * part + j) * 136 + k] = (bf16)f2bf(qs[j] * fexp(bb));
            KT2[(16 * part + j) * 136 + k] = (bf16)f2bf((1.f - fexp(lf[j])) * fexp(-bb));
        }
        __syncthreads();
        const int r = lane & 31, hh = lane >> 5, ti = wave & 1, vj = wave >> 1;
        bf16x8 pa[2][2];
#pragma unroll
        for (int sj = 0; sj < 2; ++sj) { pa[sj][0] = (bf16x8){0, 0, 0, 0, 0, 0, 0, 0}; pa[sj][1] = pa[sj][0]; }
#pragma unroll
        for (int sj = 0; sj < 2; ++sj) {
            if (sj <= ti) {
                f32x16 x = {};
#pragma unroll
                for (int ks = 0; ks < 8; ++ks) {
                    const bf16x8 a = *(const LAS bf16x8*)(KT2 + (32 * sj + r) * 136 + 16 * ks + 8 * hh);
                    const bf16x8 bq = *(const LAS bf16x8*)(QT + (32 * ti + r) * 136 + 16 * ks + 8 * hh);
                    x = __builtin_amdgcn_mfma_f32_32x32x16_bf16(a, bq, x, 0, 0, 0);
                }
                if (sj == ti) {
#pragma unroll
                    for (int i = 0; i < 16; ++i) if (crow(i, hh) > r) x[i] = 0.f;
                }
#pragma unroll
                for (int s2 = 0; s2 < 2; ++s2) { v4u pw; pw.x = pk2(x[8 * s2], x[8 * s2 + 1]); pw.y = pk2(x[8 * s2 + 2], x[8 * s2 + 3]); pw.z = pk2(x[8 * s2 + 4], x[8 * s2 + 5]); pw.w = pk2(x[8 * s2 + 6], x[8 * s2 + 7]);
                    pa[sj][s2] = __builtin_bit_cast(bf16x8, pw); }
            }
        }
        f32x16 o = {};
        { const bf16* Sg = LS + (size_t)u * 16384 + (size_t)(32 * vj + r) * 128 + 8 * hh;
#pragma unroll
          for (int ks = 0; ks < 8; ++ks) {
              const bf16x8 a = *(const LAS bf16x8*)(QT + (32 * ti + r) * 136 + 16 * ks + 8 * hh);
              const bf16x8 bs = *(const bf16x8*)(Sg + 16 * ks);
              o = __builtin_amdgcn_mfma_f32_32x32x16_bf16(a, bs, o, 0, 0, 0);
          } }
#pragma unroll
        for (int sj = 0; sj < 2; ++sj) {
            if (sj <= ti) {
#pragma unroll
                for (int s2 = 0; s2 < 2; ++s2) {
                    const LAS bf16* vp = VT + (32 * vj + r) * 72 + 32 * sj + 16 * s2 + 4 * hh;
                    const s16x4 lo = *(const LAS s16x4*)vp, hi4 = *(const LAS s16x4*)(vp + 8);
                    const bf16x8 pb = (bf16x8){lo[0], lo[1], lo[2], lo[3], hi4[0], hi4[1], hi4[2], hi4[3]};
                    o = __builtin_amdgcn_mfma_f32_32x32x16_bf16(pa[sj][s2], pb, o, 0, 0, 0);
                }
            }
        }
#pragma unroll
        for (int i = 0; i < 16; ++i) OL[(32 * ti + crow(i, hh)) * 132 + 32 * vj + r] = o[i];
        __syncthreads();
        {
            const int t = tid >> 3, vp = tid & 7;
            f32x4 ov[4]; float ss = 0.f;
#pragma unroll
            for (int q = 0; q < 4; ++q) { ov[q] = *(const LAS f32x4*)(OL + t * 132 + 16 * vp + 4 * q); ss += (ov[q][0] * ov[q][0] + ov[q][1] * ov[q][1]) + (ov[q][2] * ov[q][2] + ov[q][3] * ov[q][3]); }
            ss += __shfl_xor(ss, 1); ss += __shfl_xor(ss, 2); ss += __shfl_xor(ss, 4);
            const float rstd = 1.0f / sqrtf(ss * (1.f / 128.f) + EPS);
            const size_t off = (row0 + t) * D + h * 128 + 16 * vp;
            const v4u g0 = *(const v4u*)(HG + off), g1 = *(const v4u*)(HG + off + 8);
            const f32x4* gn = (const f32x4*)(gnorm + 16 * vp);
            const f32x4 n0 = gn[0], n1 = gn[1], n2 = gn[2], n3 = gn[3];
            v4u w0, w1;
            w0.x = pk2(ov[0][0] * rstd * n0[0] * bflo(g0.x), ov[0][1] * rstd * n0[1] * bfhi(g0.x)); w0.y = pk2(ov[0][2] * rstd * n0[2] * bflo(g0.y), ov[0][3] * rstd * n0[3] * bfhi(g0.y));
            w0.z = pk2(ov[1][0] * rstd * n1[0] * bflo(g0.z), ov[1][1] * rstd * n1[1] * bfhi(g0.z)); w0.w = pk2(ov[1][2] * rstd * n1[2] * bflo(g0.w), ov[1][3] * rstd * n1[3] * bfhi(g0.w));
            w1.x = pk2(ov[2][0] * rstd * n2[0] * bflo(g1.x), ov[2][1] * rstd * n2[1] * bfhi(g1.x)); w1.y = pk2(ov[2][2] * rstd * n2[2] * bflo(g1.y), ov[2][3] * rstd * n2[3] * bfhi(g1.y));
            w1.z = pk2(ov[3][0] * rstd * n3[0] * bflo(g1.z), ov[3][1] * rstd * n3[1] * bfhi(g1.z)); w1.w = pk2(ov[3][2] * rstd * n3[2] * bflo(g1.w), ov[3][3] * rstd * n3[3] * bfhi(g1.w));
            *(v4u*)(HQ + off) = w0; *(v4u*)(HQ + off + 8) = w1;
        }
        __syncthreads();
    }
}
__device__ __forceinline__ void final_norm(float* out, const float* ss2, const float* g, int G) {
    int tid_ = threadIdx.x; asm volatile("" : "+v"(tid_)); const int tid = tid_, lane = tid & 63, wave = tid >> 6;
    const int gw = blockIdx.x * NWAVES + wave, NGW = G * NWAVES;
    f32x4 gm[4];
#pragma unroll
    for (int j = 0; j < 4; ++j) gm[j] = ((const f32x4*)g)[lane + 64 * j];
    for (int m = gw; m < M; m += NGW) {
        f32x4* xr = (f32x4*)(out + (size_t)m * D) + lane;
        const float rstd = 1.0f / sqrtf(ss2[m] * (1.f / D) + EPS);
#pragma unroll
        for (int j = 0; j < 4; ++j) xr[64 * j] = xr[64 * j] * rstd * gm[j];
    }
}

#define XB_TMO      128
#define XB_XCNT(j)  (256  + 64 * (j))
#define XB_XSUB(j)  (1280 + 64 * (j))
#define XB_XGEN(j)  (2304 + 64 * (j))
#define XB_TOP      3328
#define XB_TOPGEN   3392
#define XCD_BAR_WORDS 3456
#define XB_SPIN_CAP (1u << 18)

__device__ __forceinline__ unsigned xb_ld(unsigned* p)              { return __hip_atomic_load(p, __ATOMIC_RELAXED, __HIP_MEMORY_SCOPE_AGENT); }
__device__ __forceinline__ unsigned xb_add(unsigned* p, unsigned v) { return __hip_atomic_fetch_add(p, v, __ATOMIC_RELAXED, __HIP_MEMORY_SCOPE_AGENT); }
__device__ __forceinline__ unsigned xb_xcc_id() { return (unsigned)__builtin_amdgcn_s_getreg((3 << 11) | 20) & 0xFu; }
#define XB_SPIN(cond, bar) do { unsigned _sp = 0; while (cond) { __builtin_amdgcn_s_sleep(1); \
    if ((++_sp & 255u) == 0u) { if (xb_ld(&(bar)[XB_TMO])) break; if (_sp > XB_SPIN_CAP) { atomicAdd(&(bar)[XB_TMO], 1u); break; } } } } while (0)

struct XcdBarrier {
    unsigned* bar; unsigned x;
    volatile LAS unsigned* st;
};

__device__ __forceinline__ XcdBarrier xcd_barrier_post(unsigned* bar, volatile LAS unsigned* st) {
    XcdBarrier b; b.bar = bar; b.x = xb_xcc_id(); b.st = st;
    if (threadIdx.x == 0) (void)xb_add(&bar[XB_XCNT(b.x)], 1u);
    return b;
}
__device__ __forceinline__ void xcd_barrier_complete(unsigned* bar, unsigned x, unsigned& nloc, unsigned& nx) {
    const unsigned G = gridDim.x * gridDim.y * gridDim.z;
    unsigned sum, cnt, mine, sp = 0u;
    for (;;) {
        sum = 0u; cnt = 0u; mine = 0u;
#pragma unroll
        for (unsigned j = 0; j < 16; ++j) { const unsigned c = xb_ld(&bar[XB_XCNT(j)]); sum += c; cnt += (c > 0u) ? 1u : 0u; mine = (j == x) ? c : mine; }
        if (sum == G) break;
        __builtin_amdgcn_s_sleep(1);
        if ((++sp & 255u) == 0u) { if (xb_ld(&bar[XB_TMO])) break; if (sp > XB_SPIN_CAP) { atomicAdd(&bar[XB_TMO], 1u); break; } }
    }
    nloc = mine > 0u ? mine : 1u; nx = cnt > 0u ? cnt : 1u;
}

__device__ __forceinline__ void xcd_barrier(const XcdBarrier& b) {
    asm volatile("s_waitcnt vmcnt(0)" ::: "memory");
    __syncthreads();
    if (threadIdx.x == 0) {
        unsigned* bar = b.bar;
        __builtin_amdgcn_s_waitcnt(0);
        unsigned nloc = b.st[0], nx = b.st[1];
        if (nloc == 0u) { xcd_barrier_complete(bar, b.x, nloc, nx); b.st[0] = nloc; b.st[1] = nx; }
        const unsigned old = xb_add(&bar[XB_XSUB(b.x)], 1u);
        const unsigned gen = old / nloc;
        if (old + 1u == (gen + 1u) * nloc) {
            __builtin_amdgcn_fence(__ATOMIC_RELEASE, "agent");
            asm volatile("s_waitcnt vmcnt(0)" ::: "memory");
            const unsigned og = xb_add(&bar[XB_TOP], 1u);
            const unsigned tg = og / nx;
            if (og + 1u == (tg + 1u) * nx) xb_add(&bar[XB_TOPGEN], 1u);
            else XB_SPIN(xb_ld(&bar[XB_TOPGEN]) == tg, bar);
            __builtin_amdgcn_fence(__ATOMIC_ACQUIRE, "agent");
            xb_add(&bar[XB_XGEN(b.x)], 1u);
            asm volatile("s_waitcnt vmcnt(0)" ::: "memory");
        } else {
            XB_SPIN(xb_ld(&bar[XB_XGEN(b.x)]) == gen, bar);
            __builtin_amdgcn_fence(__ATOMIC_ACQUIRE, "agent");
            asm volatile("s_waitcnt vmcnt(0)" ::: "memory");
        }
    }
    __syncthreads();
}

struct Args { const float* in[15]; float* out; unsigned char* ws; int ph_lo, ph_hi; };
#ifndef NOPH0
#define NOPH0 0
#endif
#ifndef NOPH1
#define NOPH1 0
#endif
#ifndef NOPH2
#define NOPH2 0
#endif
#ifndef NOPH3
#define NOPH3 0
#endif
#ifndef NOPH4
#define NOPH4 0
#endif
#ifndef NOPH5
#define NOPH5 0
#endif
#ifndef NOPH6
#define NOPH6 0
#endif
#ifndef NOPH7
#define NOPH7 0
#endif
#ifndef NOPH8
#define NOPH8 0
#endif
#ifndef NOPH9
#define NOPH9 0
#endif
#ifndef NOPH10
#define NOPH10 0
#endif
#ifndef NOPH11
#define NOPH11 0
#endif
#ifndef NOPH12
#define NOPH12 0
#endif
constexpr int N_PHASES = 13;
#ifndef MK_ONE_LAUNCH
#define MK_ONE_LAUNCH 1
#endif

__global__ void __launch_bounds__(NTHR, 2) hybrid_fwd(Args args) {
    extern __shared__ __attribute__((aligned(16))) unsigned char lds_raw[];
    LAS unsigned char* lds = (LAS unsigned char*)lds_raw;
    const int G = gridDim.x;
    Ptrs P;
    P.x = args.in[0]; P.norm_mix = args.in[1]; P.w_in = args.in[2]; P.fbias = args.in[3]; P.lblog = args.in[4]; P.hg_norm = args.in[5];
    P.w_a = args.in[6]; P.w_b = args.in[7]; P.w_o = args.in[8]; P.norm_ffn = args.in[9]; P.w_up = args.in[10]; P.conv_w = args.in[11]; P.conv_b = args.in[12];
    P.w_dn = args.in[13]; P.norm_final = args.in[14]; P.out = args.out; P.ws = args.ws;
    unsigned char* ws = args.ws;
    bf16* Wt_in = (bf16*)(ws + WS_WIN);
    bf16* S0 = (bf16*)(ws + WS_SLOT0); bf16* S1 = (bf16*)(ws + WS_SLOT0 + SLOT); bf16* S2 = (bf16*)(ws + WS_SLOT0 + 2 * SLOT); bf16* S3 = (bf16*)(ws + WS_SLOT0 + 3 * SLOT);
    bf16* S4 = (bf16*)(ws + WS_SLOT0 + 4 * SLOT); bf16* S5 = (bf16*)(ws + WS_SLOT0 + 5 * SLOT); bf16* S6 = (bf16*)(ws + WS_SLOT0 + 6 * SLOT); bf16* D0 = (bf16*)args.out;
    float* SS1 = (float*)(ws + WS_SS1); float* SS2 = (float*)(ws + WS_SS2);
    const int lo = args.ph_lo, hi = args.ph_hi;
#define IN(k) (lo <= (k) && (k) < hi)
    {   volatile LAS unsigned* barw = (volatile LAS unsigned*)(lds + BARW_OFF);
        if (threadIdx.x < 2) barw[threadIdx.x] = 0u;
        __syncthreads();
        if (hi - lo > 1) (void)xcd_barrier_post((unsigned*)(ws + WS_BAR), barw); }
#define SEAM(k) do { if (IN(k) && IN((k) + 1)) { if ((k) == 0) cg::this_grid().sync(); else { XcdBarrier b_; b_.bar = (unsigned*)(args.ws + WS_BAR); b_.x = xb_xcc_id(); b_.st = (volatile LAS unsigned*)(lds + BARW_OFF); xcd_barrier(b_); } } } while (0)

    if (IN(0) && !NOPH0) { p0_prologue(lds, P, G); }
    SEAM(0);
    if (IN(1) && !NOPH1) {
        p1_cscan(lds, P);
        pg8::Gemm g{S0, Wt_in + (size_t)4096 * D, M, 3072, D, 0}; pg8::StaticOrder S; S.init(M, 3072, G, (int)blockIdx.x);
        EpiProj E{S1, S2, S3, S3, 0, 0, 0, 0, attn_body::C2, nullptr};
        pg8::gemm_phase<EpiProj, pg8::StaticOrder, true, true>(lds, g, S, E);
    }
    SEAM(1);
    if (IN(2) && !NOPH2) {
        const attn_body::AttnTensors AT{(const attn_body::bf16*)S1, (const attn_body::bf16*)S2, (const attn_body::bf16*)S3, (attn_body::bf16*)S1, (const float*)(ws + WS_CL)};
        const attn_body::StaticOrder S(G, (int)blockIdx.x);
        attn_body::attn_phase<attn_body::StaticOrder>((char*)lds_raw, AT, S);
    }
    if (IN(3) && !NOPH3) {
        pg8::Gemm g{S0, Wt_in, M, 4096, D, 0}; pg8::StaticOrder S; S.init(M, 4096, G, (int)blockIdx.x);
        EpiProj E{S4, S5, S6, D0, 1, 2, 0, 1, 1.f, (const float*)(ws + WS_LBV)};
        pg8::gemm_phase<EpiProj, pg8::StaticOrder, true, true>(lds, g, S, E);
    }
    SEAM(3);
    if (IN(4) && !NOPH4) hgrn_pass_a(lds, S5, S6, S2, (float*)(ws + WS_DK), G);
    SEAM(4);
    if (IN(5) && !NOPH5) hgrn_pass_b((unsigned*)S2, (const float*)(ws + WS_DK), G);
    SEAM(5);
    if (IN(6) && !NOPH6) hgrn_pass_c(lds, S4, S5, S6, D0, S2, P.hg_norm, G);
    SEAM(6);
    if (IN(7) && !NOPH7) {
        pg8::Gemm g{S0, Wt_in + (size_t)7168 * D, M, 2048, D, 0}; pg8::StaticOrder S; S.init(M, 2048, G, (int)blockIdx.x);
        EpiProj E{S5, S6, S6, S6, 0, 0, 0, 0, 1.f, nullptr};
        pg8::gemm_phase<EpiProj, pg8::StaticOrder, true, true>(lds, g, S, E);
    }
    SEAM(7);
    if (IN(8) && !NOPH8) {
        { pg8::Gemm g{S4, (const bf16*)(ws + WS_WA), M, D, D, 0}; pg8::StaticOrder S; S.init(M, D, G, (int)blockIdx.x);
          EpiGate E{S5, nullptr, S5};
          pg8::gemm_phase<EpiGate, pg8::StaticOrder, true, true>(lds, g, S, E); }
        asm volatile("s_waitcnt vmcnt(0)" ::: "memory"); __builtin_amdgcn_fence(__ATOMIC_ACQUIRE, "agent"); asm volatile("s_waitcnt vmcnt(0)" ::: "memory"); __syncthreads();
        { pg8::Gemm g{S1, (const bf16*)(ws + WS_WB), M, D, D, 0}; pg8::StaticOrder S; S.init(M, D, G, (int)blockIdx.x);
          EpiGate E{S6, S5, S6};
          pg8::gemm_phase<EpiGate, pg8::StaticOrder, true, true>(lds, g, S, E); }
    }
    SEAM(8);
    if (IN(9) && !NOPH9) {
        pg8::Gemm g{S6, (const bf16*)(ws + WS_WO), M, D, D, 0}; pg8::StaticOrder S; S.init(M, D, G, (int)blockIdx.x);
        EpiRes E{P.x, P.out, S0, P.norm_ffn, SS1};
        pg8::gemm_phase<EpiRes, pg8::StaticOrder, true, true>(lds, g, S, E);
    }
    SEAM(9);
    if (IN(10) && !NOPH10) {
        pg8::Gemm g{S0 - 2 * D, (const bf16*)(ws + WS_WUP), UP_NM * 256, NUP, D, (size_t)UP_TM * D * 2}; pg8::StaticOrder S; S.init(UP_NM * 256, NUP, G, (int)blockIdx.x);
        EpiConvGlu E{S1, SS1, P.conv_w, P.conv_b, lds + HALO_OFF};
        pg8::gemm_phase<EpiConvGlu, pg8::StaticOrder, true, true>(lds, g, S, E);
    }
    SEAM(10);
    if (IN(11) && !NOPH11) {
        pg8::Gemm g{S1, (const bf16*)(ws + WS_WDN), M, D, DFF, 0}; pg8::StaticOrder S; S.init(M, D, G, (int)blockIdx.x);
        EpiRes E{P.out, P.out, nullptr, nullptr, SS2};
        pg8::gemm_phase<EpiRes, pg8::StaticOrder, true, true>(lds, g, S, E);
    }
    SEAM(11);
    if (IN(12) && !NOPH12) final_norm(P.out, SS2, P.norm_final, G);
#undef IN
#undef SEAM
}

extern "C" void kernel_launch(void* const* d_in, const int* in_sizes, int n_in, void* d_out, int out_size, void* d_ws, size_t ws_size, hipStream_t stream) {
    static int grid = 0;
    if (grid == 0) {
        if (n_in != 15 || in_sizes[0] != M * D || out_size != M * D || ws_size < WS_END) { fprintf(stderr, "kernel_launch: unexpected shapes / workspace (%d inputs, in0 %d, out %d, ws %zu < %zu)\n", n_in, n_in > 0 ? in_sizes[0] : -1, out_size, ws_size, (size_t)WS_END); grid = -1; return; }
        int dev = 0, cus = 0, per_cu = 0;
        if (hipGetDevice(&dev) != hipSuccess || hipDeviceGetAttribute(&cus, hipDeviceAttributeMultiprocessorCount, dev) != hipSuccess) { grid = -1; return; }
        if (hipFuncSetAttribute((const void*)hybrid_fwd, hipFuncAttributeMaxDynamicSharedMemorySize, LDS_BYTES) != hipSuccess) { fprintf(stderr, "kernel_launch: hipFuncSetAttribute failed\n"); grid = -1; return; }
        if (hipOccupancyMaxActiveBlocksPerMultiprocessor(&per_cu, (const void*)hybrid_fwd, NTHR, LDS_BYTES) != hipSuccess || per_cu < 1) per_cu = 1;
        (void)hipGetLastError();
        grid = cus;
    }
    if (grid < 0) return;
    if (hipMemsetAsync((char*)d_ws + WS_BAR, 0, BAR_BYTES, stream) != hipSuccess) { fprintf(stderr, "kernel_launch: memset failed\n"); return; }
    Args a{};
    for (int i = 0; i < 15; ++i) a.in[i] = (const float*)d_in[i];
    a.out = (float*)d_out; a.ws = (unsigned char*)d_ws;
#if MK_ONE_LAUNCH
    a.ph_lo = 0; a.ph_hi = N_PHASES;
    void* kargs[] = {&a};
    hipError_t e = hipLaunchCooperativeKernel((const void*)hybrid_fwd, dim3(grid), dim3(NTHR), kargs, LDS_BYTES, stream);
    if (e != hipSuccess) fprintf(stderr, "cooperative launch failed: %s (grid %d)\n", hipGetErrorString(e), grid);
#else
    for (int p = 0; p < N_PHASES; ++p) { a.ph_lo = p; a.ph_hi = p + 1; hipLaunchKernelGGL(hybrid_fwd, dim3(grid), dim3(NTHR), LDS_BYTES, stream, a); }
#endif
}
```

```cpp
#include <hip/hip_runtime.h>
#include <hip/hip_cooperative_groups.h>
#include <hip/hip_runtime.h>
#include <cstdio>
#include <cstdint>
namespace pg8 {
#define PG8_LAS __attribute__((address_space(3)))
typedef unsigned short bf16_t;
typedef short bf16x8 __attribute__((ext_vector_type(8)));
typedef float f32x4 __attribute__((ext_vector_type(4)));
typedef unsigned u32x4 __attribute__((ext_vector_type(4)));
constexpr int BM = 256, BK = 64, HALF = 128, HTB = HALF * BK * 2  , STAGE_BYTES = 8 * HTB, NXCD = 8, WGM = 8;

__host__ __device__ __forceinline__ int lds_byte(int r, int c) { const int st = (r >> 4) * 2 + (c >> 5), rr = r & 15, cc = c & 31, ob = rr * 64 + cc * 2; return st * 1024 + (ob ^ (((ob >> 9) & 1) << 5)); }
__host__ __device__ __forceinline__ void stage_rc(int b, int& R, int& C) { const int st = b / 1024, sb = b % 1024, swz = sb ^ (((sb >> 9) & 1) << 5); R = (st >> 1) * 16 + swz / 64; C = (st & 1) * 32 + (swz % 64) / 2; }
__host__ __device__ __forceinline__ int perm32(int rho) { const int n = rho >> 4, i = rho & 15; return 8 * (i >> 2) + 4 * n + (i & 3); }

struct Unit { int pm, pn; };
struct Gemm { const bf16_t* A; const bf16_t* Bt; int M, N, K; size_t a_tstep; };

struct StaticOrder {
    int nM, nN, nwg, G, c;
    __host__ __device__ void init(int M, int N, int G_, int c_) { nM = M / BM; nN = N / BM; nwg = nM * nN; G = G_; c = c_; }
    __host__ __device__ bool next(int i, Unit& u) const {
        const long L = (long)i * G + c; if (L >= nwg) return false;
        int wgid = (int)L; { const int q = nwg / NXCD, r = nwg % NXCD, xcd = wgid % NXCD, off = wgid / NXCD; wgid = (xcd < r ? xcd * (q + 1) : r * (q + 1) + (xcd - r) * q) + off; }
        const int nig = WGM * nN, gid = wgid / nig, fm = gid * WGM, gsz = (nM - fm) < WGM ? (nM - fm) : WGM;
        u.pm = fm + ((wgid % nig) % gsz); u.pn = (wgid % nig) / gsz; return true;
    }
    __device__ __forceinline__ void a_ready(const Unit&) const {}
    __device__ __forceinline__ void done(const Unit&) const {}
};

__device__ __forceinline__ unsigned cvt_pk_bf16(float lo, float hi) { unsigned r; asm volatile("v_cvt_pk_bf16_f32 %0, %1, %2" : "=v"(r) : "v"(lo), "v"(hi)); return r; }
typedef float f32x2 __attribute__((ext_vector_type(2)));
__device__ __forceinline__ f32x2 gelu_pk(f32x2 v) {
    const f32x2 av = __builtin_elementwise_abs(v), d = av * 0.2316418882f + 1.0f;
    f32x2 t; t.x = __builtin_amdgcn_rcpf(d.x); t.y = __builtin_amdgcn_rcpf(d.y);
    f32x2 q = t * 0.5307027145f + (-0.7265760135f); q = q * t + 0.7107068705f; q = q * t + (-0.142248368f); q = q * t + 0.127414796f; q = q * t;
    const f32x2 s = (v * v) * (-0.72134752044f);
    f32x2 e; e.x = __builtin_amdgcn_exp2f(s.x); e.y = __builtin_amdgcn_exp2f(s.y);
    const f32x2 m = v * (q * e), r = v - m;
    f32x2 o; o.x = v.x < 0.f ? m.x : r.x; o.y = v.y < 0.f ? m.y : r.y; return o;
}

template <class E, class = void> struct epi_perma { static constexpr bool value = false; };
template <class E> struct epi_perma<E, decltype((void)E::PERMA)> { static constexpr bool value = E::PERMA; };
template <class Epi, class Sched, bool ALIGN_EPI = false, bool SP2 = false>
__device__ __forceinline__ void gemm_phase(PG8_LAS unsigned char* lds, const Gemm g, const Sched& S, const Epi& E, int tid0) {
    int tid_ = tid0; asm volatile("" : "+v"(tid_));
    const int tid = tid_, wid = __builtin_amdgcn_readfirstlane(tid >> 6), lane = tid & 63, wr = wid >> 2, wc = wid & 3, fr = lane & 15, fq = lane >> 4;
    const int K = g.K, nt = K / BK;
    unsigned voffA[2], voffB[2];
#pragma unroll
    for (int i = 0; i < 2; ++i) { int R, C; stage_rc(tid * 16 + i * 8192, R, C); const int Rb = Epi::PERM ? ((R & ~31) + perm32(R & 31)) : R;
        const int Ra = epi_perma<Epi>::value ? ((R & ~63) + 4 * (R & 15) + ((R >> 4) & 3)) : R;
        voffA[i] = (unsigned)(Ra * K + C) * 2u; voffB[i] = (unsigned)(Rb * K + C) * 2u; }
    const size_t kstep = (size_t)(BK * 2);
    const size_t hstep = (size_t)HALF * K * 2;
    const size_t tstep = 2 * hstep;
    const unsigned ldsw = (unsigned)wid * 1024u;
    const int aoff = lds_byte(wr * 64 + fr, fq * 8), boff = lds_byte(wc * 32 + fr, fq * 8);
#define PG8_SA(b, h) (((b) * 2 + (h)) * HTB)
#define PG8_SB(b, h) ((4 + (b) * 2 + (h)) * HTB)
#define PG8_STAGE(bufoff, gbase, voff) do { _Pragma("unroll") for (int _i = 0; _i < 2; ++_i) \
        __builtin_amdgcn_global_load_lds((const unsigned*)((const char*)(gbase) + (voff)[_i]), (PG8_LAS unsigned*)(lds + (bufoff) + ldsw + _i * 8192), 16, 0, 0); } while (0)
#define PG8_LDA(dst, b, h) do { _Pragma("unroll") for (int m = 0; m < 4; ++m) _Pragma("unroll") for (int k = 0; k < 2; ++k) dst[m][k] = *(const PG8_LAS bf16x8*)(lds + PG8_SA(b, h) + aoff + m * 2048 + k * 1024); } while (0)
#define PG8_LDB(dst, b, h) do { _Pragma("unroll") for (int n = 0; n < 2; ++n) _Pragma("unroll") for (int k = 0; k < 2; ++k) dst[n][k] = *(const PG8_LAS bf16x8*)(lds + PG8_SB(b, h) + boff + n * 2048 + k * 1024); } while (0)
#define PG8_MMA(ai, bj, At, Bt) do { __builtin_amdgcn_s_setprio(1); _Pragma("unroll") for (int m = 0; m < 4; ++m) _Pragma("unroll") for (int n = 0; n < 2; ++n) _Pragma("unroll") for (int k = 0; k < 2; ++k) \
        acc[ai][bj][m][n] = __builtin_amdgcn_mfma_f32_16x16x32_bf16(Bt[n][k], At[m][k], acc[ai][bj][m][n], 0, 0, 0); __builtin_amdgcn_s_setprio(0); } while (0)
#define PG8_WAIT_V(n) asm volatile("s_waitcnt vmcnt(" #n ")" ::: "memory")
#define PG8_WAIT_L(n) asm volatile("s_waitcnt lgkmcnt(" #n ")" ::: "memory")
#define PG8_BAR __builtin_amdgcn_s_barrier()
#define PG8_SCHED __builtin_amdgcn_sched_barrier(0)
    Unit cur, nxt; int ui = 0;
    if (!S.next(0, cur)) return;
    f32x4 acc[2][2][4][2];
#pragma unroll
    for (int a = 0; a < 2; ++a)
#pragma unroll
        for (int b = 0; b < 2; ++b)
#pragma unroll
            for (int m = 0; m < 4; ++m)
#pragma unroll
                for (int n = 0; n < 2; ++n) acc[a][b][m][n] = (f32x4){0.f, 0.f, 0.f, 0.f};
    bf16x8 At[4][2], B0[2][2], B1[2][2];
    const size_t tstepA = g.a_tstep ? g.a_tstep : tstep; const char* cA = (const char*)g.A + (size_t)cur.pm * tstepA; const char* cB = (const char*)g.Bt + (size_t)cur.pn * tstep;
    S.a_ready(cur);
    if constexpr (SP2) {
        PG8_STAGE(PG8_SB(0, 0), cB, voffB); PG8_STAGE(PG8_SB(0, 1), cB + hstep, voffB); PG8_STAGE(PG8_SA(0, 0), cA, voffA); PG8_STAGE(PG8_SA(0, 1), cA + hstep, voffA);
        if (wr == 1) PG8_BAR;
        PG8_WAIT_V(2); PG8_BAR;
        PG8_STAGE(PG8_SB(1, 0), cB + kstep, voffB); PG8_STAGE(PG8_SA(1, 0), cA + kstep, voffA); PG8_STAGE(PG8_SB(1, 1), cB + hstep + kstep, voffB);
        PG8_WAIT_V(6); PG8_BAR;
    } else {
        PG8_STAGE(PG8_SB(0, 0), cB, voffB); PG8_STAGE(PG8_SA(0, 0), cA, voffA); PG8_STAGE(PG8_SB(0, 1), cB + hstep, voffB); PG8_STAGE(PG8_SA(0, 1), cA + hstep, voffA);
        if (wr == 1) PG8_BAR;
        PG8_WAIT_V(4); PG8_BAR;
        PG8_STAGE(PG8_SB(1, 0), cB + kstep, voffB); PG8_STAGE(PG8_SA(1, 0), cA + kstep, voffA); PG8_STAGE(PG8_SB(1, 1), cB + hstep + kstep, voffB);
        PG8_WAIT_V(6); PG8_BAR;
    }
    for (;;) {
        const bool has_next = S.next(ui + 1, nxt);
        const char* nA = has_next ? (const char*)g.A + (size_t)nxt.pm * tstepA : cA; const char* nB = has_next ? (const char*)g.Bt + (size_t)nxt.pn * tstep : cB;
        for (int t = 0; t < nt; t += 2) {
            const bool last = (t == nt - 2);
            const char* a1 = cA + (size_t)(t + 1) * kstep;
            const char* a2 = last ? nA : cA + (size_t)(t + 2) * kstep; const char* b2 = last ? nB : cB + (size_t)(t + 2) * kstep;
            const char* a3 = a2 + kstep; const char* b3 = b2 + kstep;
            if (last && has_next) S.a_ready(nxt);
            if constexpr (SP2) {
            PG8_LDB(B0, 0, 0); PG8_LDB(B1, 0, 1); PG8_SCHED; PG8_LDA(At, 0, 0); PG8_STAGE(PG8_SA(1, 1), a1 + hstep, voffA);
            PG8_WAIT_V(8); PG8_WAIT_L(0); PG8_BAR; PG8_MMA(0, 0, At, B0); PG8_MMA(0, 1, At, B1); PG8_BAR; PG8_SCHED;
            PG8_LDA(At, 0, 1); PG8_STAGE(PG8_SB(0, 0), b2, voffB); PG8_STAGE(PG8_SB(0, 1), b2 + hstep, voffB); PG8_STAGE(PG8_SA(0, 0), a2, voffA);
            PG8_WAIT_V(8); PG8_WAIT_L(0); PG8_BAR; PG8_MMA(1, 0, At, B0); PG8_MMA(1, 1, At, B1); PG8_BAR; PG8_SCHED;
            PG8_LDB(B0, 1, 0); PG8_LDB(B1, 1, 1); PG8_SCHED; PG8_LDA(At, 1, 0); PG8_STAGE(PG8_SA(0, 1), a2 + hstep, voffA);
            PG8_WAIT_V(8); PG8_WAIT_L(0); PG8_BAR; PG8_MMA(0, 0, At, B0); PG8_MMA(0, 1, At, B1); PG8_BAR; PG8_SCHED;
            PG8_LDA(At, 1, 1); PG8_STAGE(PG8_SB(1, 0), b3, voffB); PG8_STAGE(PG8_SB(1, 1), b3 + hstep, voffB); PG8_STAGE(PG8_SA(1, 0), a3, voffA);
            PG8_WAIT_V(8); PG8_WAIT_L(0); PG8_BAR; PG8_MMA(1, 0, At, B0); PG8_MMA(1, 1, At, B1); PG8_BAR; PG8_SCHED;
            } else {
            PG8_LDB(B0, 0, 0); PG8_SCHED; PG8_LDA(At, 0, 0); PG8_STAGE(PG8_SA(1, 1), a1 + hstep, voffA);
            PG8_WAIT_L(8); PG8_BAR; PG8_WAIT_L(0); PG8_MMA(0, 0, At, B0); PG8_BAR; PG8_SCHED;
            PG8_LDB(B1, 0, 1); PG8_STAGE(PG8_SB(0, 0), b2, voffB);
            PG8_BAR; PG8_WAIT_L(0); PG8_MMA(0, 1, At, B1); PG8_BAR;
            PG8_LDA(At, 0, 1); PG8_STAGE(PG8_SA(0, 0), a2, voffA);
            PG8_BAR; PG8_WAIT_L(0); PG8_MMA(1, 0, At, B0); PG8_BAR; PG8_SCHED;
            PG8_STAGE(PG8_SB(0, 1), b2 + hstep, voffB);
            PG8_WAIT_V(6); PG8_BAR; PG8_MMA(1, 1, At, B1); PG8_BAR;
            PG8_LDB(B0, 1, 0); PG8_SCHED; PG8_LDA(At, 1, 0); PG8_STAGE(PG8_SA(0, 1), a2 + hstep, voffA);
            PG8_WAIT_L(8); PG8_BAR; PG8_WAIT_L(0); PG8_MMA(0, 0, At, B0); PG8_BAR; PG8_SCHED;
            PG8_LDB(B1, 1, 1); PG8_STAGE(PG8_SB(1, 0), b3, voffB);
            PG8_BAR; PG8_WAIT_L(0); PG8_MMA(0, 1, At, B1); PG8_BAR;
            PG8_LDA(At, 1, 1); PG8_STAGE(PG8_SA(1, 0), a3, voffA);
            PG8_BAR; PG8_WAIT_L(0); PG8_MMA(1, 0, At, B0); PG8_BAR; PG8_SCHED;
            PG8_STAGE(PG8_SB(1, 1), b3 + hstep, voffB);
            PG8_WAIT_V(6); PG8_BAR; PG8_MMA(1, 1, At, B1); PG8_BAR;
            }
        }
        if constexpr (ALIGN_EPI) { if (wr == 0) PG8_BAR; }
        if constexpr (!Epi::AFTER_DRAIN) { E(acc, cur, wr, wc, fr, fq); S.done(cur); }
        if (!has_next) break;
#pragma unroll
        for (int a = 0; a < 2; ++a)
#pragma unroll
            for (int b = 0; b < 2; ++b)
#pragma unroll
                for (int m = 0; m < 4; ++m)
#pragma unroll
                    for (int n = 0; n < 2; ++n) acc[a][b][m][n] = (f32x4){0.f, 0.f, 0.f, 0.f};
        cur = nxt; cA = nA; cB = nB; ++ui;
        if constexpr (ALIGN_EPI) { if (wr == 1) PG8_BAR; }
    }
    PG8_WAIT_V(0);
    if constexpr (!ALIGN_EPI) { if (wr == 0) PG8_BAR; }
    PG8_BAR;
    if constexpr (Epi::AFTER_DRAIN) { E.fused(acc, cur, wr, wc, fr, fq, lds, wid, lane); S.done(cur); }
#undef PG8_SA
#undef PG8_SB
#undef PG8_STAGE
#undef PG8_LDA
#undef PG8_LDB
#undef PG8_MMA
#undef PG8_WAIT_V
#undef PG8_WAIT_L
#undef PG8_BAR
#undef PG8_SCHED
}
}

#ifndef PG8_SP2
#define PG8_SP2 true
#endif
#ifndef PG8_ALIGN
#define PG8_ALIGN true
#endif
#include <hip/hip_bf16.h>
#include <cmath>
namespace attn_body {
using bf16=__hip_bfloat16;
using bf16x8=__attribute__((ext_vector_type(8)))short;
using s16x4=__attribute__((ext_vector_type(4)))short;
using f32x16=__attribute__((ext_vector_type(16)))float;
using u32x4=__attribute__((ext_vector_type(4)))unsigned;
constexpr int BATCH=4,NHEAD=16,SEQ=8192,D=64,DM=NHEAD*D;
constexpr int NW=8,QBLK=32,QB=QBLK*NW,KVBLK=64,NQB=SEQ/QB;
constexpr int ATTN_PITCH=DM, ATTN_UNIT_ROWS=QB;
__device__ __forceinline__ int crow(int r,int hi){return (r&3)+8*(r>>2)+4*hi;}
#define SBAR() __builtin_amdgcn_sched_barrier(0)
__device__ __forceinline__ void cmask(f32x16&p0,f32x16&p1,int jb,int qrel,int hi){
  const float NEG=-INFINITY; int kb=64*jb+4*hi;
  #pragma unroll
  for(int r=0;r<16;++r){int kv=kb+(r&3)+8*(r>>2); if(kv>qrel)p0[r]=NEG; if(kv+32>qrel)p1[r]=NEG;}
}

constexpr int NSLOT=3, SLOTB=8192;
constexpr int LDS_K=0, LDS_V=NSLOT*SLOTB, LDS_WS=2*NSLOT*SLOTB, LDS_OST=LDS_WS+NW*64*4, LDS_CB=LDS_OST+NW*4096, LDS_BYTES=LDS_CB+SEQ*8;
constexpr float C2=0.125f*1.4426950408889634f;
__device__ __forceinline__ void glds16(const void*gsrc,unsigned lds_dst){unsigned keep;
  asm volatile("s_mov_b32 %0, m0\n\ts_mov_b32 m0, %2\n\ts_nop 0\n\tglobal_load_lds_dwordx4 %1, off\n\ts_mov_b32 m0, %0":"=&s"(keep):"v"(gsrc),"s"(lds_dst):"memory");}
__device__ __forceinline__ float max3f(float a,float b,float c){float r;asm("v_max3_f32 %0, %1, %2, %3":"=v"(r):"v"(a),"v"(b),"v"(c));return r;}
__device__ __forceinline__ float max2f(float a,float b){float r;asm("v_max_f32_e32 %0, %1, %2":"=v"(r):"v"(a),"v"(b));return r;}
__device__ __forceinline__ float fadd_s(float a,float b){float r;asm("v_add_f32_e32 %0, %1, %2":"=v"(r):"v"(a),"v"(b));return r;}
__device__ __forceinline__ float fsub_s(float a,float b){float r;asm("v_sub_f32_e32 %0, %1, %2":"=v"(r):"v"(a),"v"(b));return r;}
typedef float f32x2_t __attribute__((ext_vector_type(2))); typedef float f32x4_t __attribute__((ext_vector_type(4))); typedef __bf16 bf16x2_t __attribute__((ext_vector_type(2)));
__device__ __forceinline__ unsigned cvtpk_s(float lo,float hi){f32x2_t v={lo,hi};bf16x2_t b=__builtin_convertvector(v,bf16x2_t);return __builtin_bit_cast(unsigned,b);}
#define WAIT_BAR(N) asm volatile("s_waitcnt vmcnt(" #N ") lgkmcnt(0)\n\ts_barrier":::"memory")

__device__ __forceinline__ void qkt(f32x16&p0,f32x16&p1,const char*Kslot,const bf16x8*qr,const f32x16&negm,int r32,int hi){
  const char*kb=Kslot+hi*1024+r32*16;
  #pragma unroll
  for(int d0=0;d0<4;++d0){
    const bf16x8 b0=*reinterpret_cast<const bf16x8*>(kb+d0*2048);
    const bf16x8 b1=*reinterpret_cast<const bf16x8*>(kb+d0*2048+512);
    if(d0==0){p0=__builtin_amdgcn_mfma_f32_32x32x16_bf16(b0,qr[0],negm,0,0,0);p1=__builtin_amdgcn_mfma_f32_32x32x16_bf16(b1,qr[0],negm,0,0,0);}
    else{p0=__builtin_amdgcn_mfma_f32_32x32x16_bf16(b0,qr[d0],p0,0,0,0);p1=__builtin_amdgcn_mfma_f32_32x32x16_bf16(b1,qr[d0],p1,0,0,0);}}
}
typedef __attribute__((address_space(3))) const char* lds_cptr;
typedef short v4i16_t __attribute__((ext_vector_type(4)));
__device__ __forceinline__ void kload8(bf16x8*kf,lds_cptr kp){
  kf[0]=*(const __attribute__((address_space(3))) bf16x8*)(kp);      kf[1]=*(const __attribute__((address_space(3))) bf16x8*)(kp+512);
  kf[2]=*(const __attribute__((address_space(3))) bf16x8*)(kp+2048); kf[3]=*(const __attribute__((address_space(3))) bf16x8*)(kp+2560);
  kf[4]=*(const __attribute__((address_space(3))) bf16x8*)(kp+4096); kf[5]=*(const __attribute__((address_space(3))) bf16x8*)(kp+4608);
  kf[6]=*(const __attribute__((address_space(3))) bf16x8*)(kp+6144); kf[7]=*(const __attribute__((address_space(3))) bf16x8*)(kp+6656);
}
__device__ __forceinline__ void kload2(bf16x8*kf,lds_cptr kp,int j){ kf[2*j]=*(const __attribute__((address_space(3))) bf16x8*)(kp+j*2048); kf[2*j+1]=*(const __attribute__((address_space(3))) bf16x8*)(kp+j*2048+512); }
__device__ __forceinline__ s16x4 vtr(lds_cptr p){ return __builtin_bit_cast(s16x4,__builtin_amdgcn_ds_read_tr16_b64_v4i16((__attribute__((address_space(3))) v4i16_t*)p)); }
__device__ __forceinline__ float rowmax(const f32x16&p0,const f32x16&p1){
  float a=max3f(p0[0],p0[1],p1[0]),b=max3f(p0[2],p0[3],p1[1]);a=max3f(a,p1[2],p1[3]);
  #pragma unroll
  for(int r=4;r<16;r+=4){a=max3f(a,p0[r],p0[r+1]);b=max3f(b,p0[r+2],p0[r+3]);a=max3f(a,p1[r],p1[r+1]);b=max3f(b,p1[r+2],p1[r+3]);}
  const float m=max2f(a,b);
  auto rr=__builtin_amdgcn_permlane32_swap(__float_as_uint(m),__float_as_uint(m),false,false);
  return max2f(__uint_as_float(rr[0]),__uint_as_float(rr[1]));
}
__device__ __forceinline__ void pv(f32x16*o,int vb,bf16x8 pa0,bf16x8 pa1,bf16x8 pa2,bf16x8 pa3){
  #pragma unroll
  for(int d0=0;d0<2;++d0){s16x4 lo[4],hi[4];
    #pragma unroll
    for(int ks=0;ks<4;++ks){
      asm volatile("ds_read_b64_tr_b16 %0,%1 offset:%c2":"=&v"(lo[ks]):"v"(vb),"i"(d0*4096+ks*1024):"memory");
      asm volatile("ds_read_b64_tr_b16 %0,%1 offset:%c2":"=&v"(hi[ks]):"v"(vb),"i"(d0*4096+ks*1024+512):"memory");}
    asm volatile("s_waitcnt lgkmcnt(0)":::"memory");SBAR();
    #define PK(k) (bf16x8){lo[k][0],lo[k][1],lo[k][2],lo[k][3],hi[k][0],hi[k][1],hi[k][2],hi[k][3]}
    o[d0]=__builtin_amdgcn_mfma_f32_32x32x16_bf16(pa0,PK(0),o[d0],0,0,0);
    o[d0]=__builtin_amdgcn_mfma_f32_32x32x16_bf16(pa1,PK(1),o[d0],0,0,0);
    o[d0]=__builtin_amdgcn_mfma_f32_32x32x16_bf16(pa2,PK(2),o[d0],0,0,0);
    o[d0]=__builtin_amdgcn_mfma_f32_32x32x16_bf16(pa3,PK(3),o[d0],0,0,0);
    #undef PK
  }
}

#ifndef ATTN_STORE16
#define ATTN_STORE16(p,v) (*(u32x4*)(p)=(v))
#endif
template<int THRL> __device__ __forceinline__ void attn_unit(int b,int h,int qb,const bf16*Q,const bf16*__restrict__ K,const bf16*__restrict__ V,bf16*O,const float*__restrict__ CLbh,char*shm,int tid0){
  const int tid=tid0,lane=tid&63,r32=lane&31,hi=lane>>5; const int wid=__builtin_amdgcn_readfirstlane(tid>>6);
  const long rowbase=(long)b*SEQ; const int q0=qb*QB;
  const bf16*Qw=Q+(rowbase+q0+wid*QBLK)*DM+h*D;
  const bf16*Kh=K+rowbase*DM+h*D,*Vh=V+rowbase*DM+h*D;
  const unsigned lds0=(unsigned)(uintptr_t)shm;
  float*wsf=(float*)(shm+LDS_WS)+wid*64;
  const bf16*ksrc=Kh+(long)lane*DM+wid*8;
  const bf16*vsrc=Vh+(long)(16*(wid&3)+(lane>>2))*DM+(wid>>2)*32+(lane&3)*8;
  const unsigned kdst=lds0+LDS_K+wid*1024, vdst=lds0+LDS_V+wid*1024;
  #define DMA_K(t,slot) glds16(ksrc+(long)(t)*KVBLK*DM,(unsigned)__builtin_amdgcn_readfirstlane(kdst+(slot)))
  #define DMA_V(t,slot) glds16(vsrc+(long)(t)*KVBLK*DM,(unsigned)__builtin_amdgcn_readfirstlane(vdst+(slot)))
  const char*Kbase=shm+LDS_K; bf16x8 kf[8];
  const lds_cptr shm3=(lds_cptr)shm; const lds_cptr kp0=shm3+LDS_K+hi*1024+r32*16; const lds_cptr vp0=shm3+LDS_V+((lane>>4)&1)*32+(lane&3)*8+(4*hi+((lane&15)>>2))*64;
  const int NT=(q0+QB)/KVBLK;
  { const float cref=CLbh[q0+QB-1]; unsigned long long*cbw=(unsigned long long*)(shm+LDS_CB); const int nk_=q0+QB;
    for(int jb_=0;jb_*4*NW*64<nk_;++jb_){ float cv_[4];
      _Pragma("unroll") for(int j_=0;j_<4;++j_){ const int i_=tid+(jb_*4+j_)*NW*64; cv_[j_]=(i_<nk_)?CLbh[i_]:0.f; }
      _Pragma("unroll") for(int j_=0;j_<4;++j_){ const int i_=tid+(jb_*4+j_)*NW*64; if(i_<nk_){ const float v_=cref-cv_[j_]; const unsigned b1_=cvtpk_s(v_,0.f)&0xffffu; const float r1_=v_-__uint_as_float(b1_<<16);
        const unsigned b2_=cvtpk_s(r1_,0.f)&0xffffu; const float r2_=r1_-__uint_as_float(b2_<<16); const unsigned b3_=cvtpk_s(r2_,0.f)&0xffffu;
        cbw[i_]=(unsigned long long)(b1_|(b2_<<16))|((unsigned long long)b3_<<32); } } }
    asm volatile("s_waitcnt vmcnt(0) lgkmcnt(0)\n\ts_barrier":::"memory"); }
  const lds_cptr cbp0=(lds_cptr)shm+LDS_CB+r32*8;
  const short one_=(hi==0)?(short)0x3f80:(short)0; const s16x4 ones=(s16x4){one_,one_,one_,0};
  #define BLD(t,k) ({ const s16x4 lo_=*(const __attribute__((address_space(3))) s16x4*)(cbp0+(t)*512+(k)*256); lo_; })
  DMA_K(0,0);DMA_V(0,0);DMA_K(1,SLOTB);
  bf16x8 qr[4];
  #pragma unroll
  for(int d0=0;d0<4;++d0)qr[d0]=*reinterpret_cast<const bf16x8*>(&Qw[(long)r32*DM+d0*16+hi*8]);
  float mhat=0.f,l_reg=0.f;f32x16 o[2];o[0]=f32x16{};o[1]=f32x16{};f32x16 negm=f32x16{};asm volatile("":"+v"(negm));
  const int qrel=wid*QBLK+r32;
  const float bdiag=CLbh[q0+QB-1]-CLbh[q0+qrel];
  #define CMASK(P0,P1,t) do{int jb_=(t)-(NT-4); if(jb_>=0)cmask(P0,P1,jb_,qrel,hi);}while(0)
  bool resc=false;
  #define START(P0,P1) do{ const float rm=rowmax(P0,P1); resc=false; \
    { const float dl=__builtin_fmaxf(rm,bdiag); mhat=fadd_s(mhat,dl); \
      _Pragma("unroll") for(int r=0;r<16;++r){P0[r]=fsub_s(P0[r],dl);P1[r]=fsub_s(P1[r],dl);} \
      _Pragma("unroll") for(int r=0;r<16;++r)negm[r]=-mhat; asm volatile("":"+v"(negm)); } \
    _Pragma("unroll") for(int r=0;r<16;++r)P0[r]=__builtin_amdgcn_exp2f(P0[r]); }while(0)
  #define RESC() do{ if(resc){ asm volatile("s_waitcnt lgkmcnt(0)":::"memory"); \
      _Pragma("unroll") for(int d_=0;d_<2;++d_) _Pragma("unroll") for(int r=0;r<16;++r)o[d_][r]*=wsf[crow(r,hi)]; } }while(0)
  f32x16 pA0,pA1,pB0,pB1;
  int sl_prev=0,sl_cur=0,sl_next=SLOTB;
  #define ROT() do{sl_prev=sl_cur;sl_cur=sl_next;sl_next=(sl_next==(NSLOT-1)*SLOTB)?0:sl_next+SLOTB;}while(0)
  DMA_K(2,2*SLOTB);
  WAIT_BAR(3);
  qkt(pA0,pA1,Kbase,qr,negm,r32,hi);{const s16x4 ba0_=BLD(0,0),ba1_=BLD(0,1);pA0=__builtin_amdgcn_mfma_f32_32x32x8bf16_1k(ba0_,ones,pA0,0,0,0);pA1=__builtin_amdgcn_mfma_f32_32x32x8bf16_1k(ba1_,ones,pA1,0,0,0);}asm volatile("s_nop 15\n\ts_nop 7":"+v"(pA0),"+v"(pA1));CMASK(pA0,pA1,0);
  START(pA0,pA1);
  _Pragma("unroll") for(int r=0;r<16;++r)pA1[r]=__builtin_amdgcn_exp2f(pA1[r]);
  WAIT_BAR(0);
  DMA_K(3,0);DMA_V(1,SLOTB);
  ROT();
  kload8(kf,kp0+sl_cur);
  WAIT_BAR(2);
  s16x4 vlo[8],vhi[8]; u32x4 pw0,pw1,pw2,pw3;
  #define PKW(P,B) cvtpk_s(P[B],P[B+1])
  #define PAF(k) __builtin_bit_cast(bf16x8,pw##k)
  #define VFR(i) (bf16x8){vlo[i][0],vlo[i][1],vlo[i][2],vlo[i][3],vhi[i][0],vhi[i][1],vhi[i][2],vhi[i][3]}
  #define PIN(x) asm volatile("":"+v"(x))
  #define MX3(a,b,c) __builtin_fmaxf(__builtin_fmaxf((a),(b)),(c))
  #define GAPA(MF,A0,A1,A2,A3,W0,W1,PW) do{ MF; sacc+=A0; sacc+=A1; sacc+=A2; sacc+=A3; PIN(sacc); W0; W1; PIN(PW); SBAR(); }while(0)
  #define EX(v) __builtin_amdgcn_exp2f(v)
  #define GAPB(MF,X,B) do{ MF; X[B]=EX(X[B]); X[B+1]=EX(X[B+1]); X[B+2]=EX(X[B+2]); X[B+3]=EX(X[B+3]); PIN(X); SBAR(); }while(0)
  #define VRD(i) do{ vlo[i]=vtr(vp_+(((i)>>2)*4096+((i)&3)*1024)); vhi[i]=vtr(vp_+(((i)>>2)*4096+((i)&3)*1024+512)); }while(0)
  #define KRD(G,j) do{ if(G){ kload2(kf,kp0+sl_next,j); SBAR(); } }while(0)
  #define STEP(C0,C1,P0,P1,t,GK,GV,GL) do{ SBAR(); \
    const lds_cptr vp_=vp0+sl_prev; const s16x4 ba0_=BLD(t,0),ba1_=BLD(t,1); \
    VRD(0); SBAR(); float sacc=(P0[0]+P0[1]); \
    GAPA(C0=__builtin_amdgcn_mfma_f32_32x32x16_bf16(kf[0],qr[0],negm,0,0,0), P0[2],P0[3],P0[4],P0[5],     pw0[0]=PKW(P0,0), pw0[1]=PKW(P0,2), pw0); \
    VRD(4); SBAR(); GAPA(C1=__builtin_amdgcn_mfma_f32_32x32x16_bf16(kf[1],qr[0],negm,0,0,0), P0[6],P0[7],P0[8],P0[9],     pw0[2]=PKW(P0,4), pw0[3]=PKW(P0,6), pw0); \
    VRD(1); SBAR(); GAPA(C0=__builtin_amdgcn_mfma_f32_32x32x16_bf16(kf[2],qr[1],C0,0,0,0),   P0[10],P0[11],P0[12],P0[13], pw1[0]=PKW(P0,8), pw1[1]=PKW(P0,10), pw1); \
    VRD(5); SBAR(); GAPA(C1=__builtin_amdgcn_mfma_f32_32x32x16_bf16(kf[3],qr[1],C1,0,0,0),   P0[14],P0[15],P1[0],P1[1],   pw1[2]=PKW(P0,12),pw1[3]=PKW(P0,14), pw1); \
    VRD(2); SBAR(); GAPA(C0=__builtin_amdgcn_mfma_f32_32x32x16_bf16(kf[4],qr[2],C0,0,0,0),   P1[2],P1[3],P1[4],P1[5],     pw2[0]=PKW(P1,0), pw2[1]=PKW(P1,2), pw2); \
    VRD(6); SBAR(); GAPA(C1=__builtin_amdgcn_mfma_f32_32x32x16_bf16(kf[5],qr[2],C1,0,0,0),   P1[6],P1[7],P1[8],P1[9],     pw2[2]=PKW(P1,4), pw2[3]=PKW(P1,6), pw2); \
    VRD(3); SBAR(); GAPA(C0=__builtin_amdgcn_mfma_f32_32x32x16_bf16(kf[6],qr[3],C0,0,0,0),   P1[10],P1[11],P1[12],P1[13], pw3[0]=PKW(P1,8), pw3[1]=PKW(P1,10), pw3); \
    VRD(7); SBAR(); GAPA(C1=__builtin_amdgcn_mfma_f32_32x32x16_bf16(kf[7],qr[3],C1,0,0,0),   P1[14],P1[15],0.f,0.f,       pw3[2]=PKW(P1,12),pw3[3]=PKW(P1,14), pw3); \
    C0=__builtin_amdgcn_mfma_f32_32x32x8bf16_1k(ba0_,ones,C0,0,0,0); C1=__builtin_amdgcn_mfma_f32_32x32x8bf16_1k(ba1_,ones,C1,0,0,0); SBAR(); \
    l_reg+=sacc; \
    if(GK){DMA_K((t)+3,sl_cur);} if(GV){DMA_V((t)+1,sl_next);} \
    CMASK(C0,C1,t); \
    { float a=MX3(C0[0],C0[1],C1[0]),b=MX3(C0[2],C0[3],C1[1]); a=MX3(a,C1[2],C1[3]); \
      _Pragma("unroll") for(int r=4;r<16;r+=4){a=MX3(a,C0[r],C0[r+1]);b=MX3(b,C0[r+2],C0[r+3]);a=MX3(a,C1[r],C1[r+1]);b=MX3(b,C1[r+2],C1[r+3]);} \
      float rm=__builtin_fmaxf(a,b); { auto rr=__builtin_amdgcn_permlane32_swap(__float_as_uint(rm),__float_as_uint(rm),false,false); rm=__builtin_fmaxf(__uint_as_float(rr[0]),__uint_as_float(rr[1])); } \
      resc=false; \
      if(__builtin_expect(__any(rm>(float)THRL),0)){ const float dl=__builtin_fmaxf(rm,0.f); mhat+=dl; \
        _Pragma("unroll") for(int r=0;r<16;++r){C0[r]-=dl;C1[r]-=dl;} \
        _Pragma("unroll") for(int r=0;r<16;++r)negm[r]=-mhat; asm volatile("":"+v"(negm)); \
        const float f=__builtin_amdgcn_exp2f(-dl); l_reg*=f; if(hi==0)wsf[r32]=f; resc=true; } } \
    SBAR(); \
    GAPB(o[0]=__builtin_amdgcn_mfma_f32_32x32x16_bf16(PAF(0),VFR(0),o[0],0,0,0), C0,0); \
    GAPB(o[1]=__builtin_amdgcn_mfma_f32_32x32x16_bf16(PAF(0),VFR(4),o[1],0,0,0), C0,4); \
    KRD(GL,0); GAPB(o[0]=__builtin_amdgcn_mfma_f32_32x32x16_bf16(PAF(1),VFR(1),o[0],0,0,0), C0,8); \
    KRD(GL,1); GAPB(o[1]=__builtin_amdgcn_mfma_f32_32x32x16_bf16(PAF(1),VFR(5),o[1],0,0,0), C0,12); \
    KRD(GL,2); GAPB(o[0]=__builtin_amdgcn_mfma_f32_32x32x16_bf16(PAF(2),VFR(2),o[0],0,0,0), C1,0); \
    KRD(GL,3); GAPB(o[1]=__builtin_amdgcn_mfma_f32_32x32x16_bf16(PAF(2),VFR(6),o[1],0,0,0), C1,4); \
    GAPB(o[0]=__builtin_amdgcn_mfma_f32_32x32x16_bf16(PAF(3),VFR(3),o[0],0,0,0), C1,8); \
    GAPB(o[1]=__builtin_amdgcn_mfma_f32_32x32x16_bf16(PAF(3),VFR(7),o[1],0,0,0), C1,12); \
    }while(0)
  int t=1;
  #undef CMASK
  #define CMASK(P0,P1,t) do{}while(0)
  for(;t+5<NT;t+=2){
    STEP(pB0,pB1,pA0,pA1,t,true,true,true);     WAIT_BAR(2); RESC(); ROT();
    STEP(pA0,pA1,pB0,pB1,t+1,true,true,true);   WAIT_BAR(2); RESC(); ROT();
  }
  #undef CMASK
  #define CMASK(P0,P1,t) do{int jb_=(t)-(NT-4); if(jb_>=0)cmask(P0,P1,jb_,qrel,hi);}while(0)
  #define ENDW(tt) do{ if((tt)+3<NT){WAIT_BAR(2);} else if((tt)+2<NT){WAIT_BAR(1);} else {WAIT_BAR(0);} }while(0)
  for(;t+1<NT;t+=2){
    STEP(pB0,pB1,pA0,pA1,t,(t+3<NT),(t+1<NT),(t+1<NT));       ENDW(t);   RESC(); ROT();
    STEP(pA0,pA1,pB0,pB1,t+1,(t+4<NT),(t+2<NT),(t+2<NT));     ENDW(t+1); RESC(); ROT();
  }
  STEP(pB0,pB1,pA0,pA1,NT-1,false,false,false); RESC();
  { float sacc=pB0[0]+pB0[1]; _Pragma("unroll") for(int r=2;r<16;++r)sacc+=pB0[r]; _Pragma("unroll") for(int r=0;r<16;++r)sacc+=pB1[r]; l_reg+=sacc;
    pw0=(u32x4){PKW(pB0,0),PKW(pB0,2),PKW(pB0,4),PKW(pB0,6)};pw1=(u32x4){PKW(pB0,8),PKW(pB0,10),PKW(pB0,12),PKW(pB0,14)};pw2=(u32x4){PKW(pB1,0),PKW(pB1,2),PKW(pB1,4),PKW(pB1,6)};pw3=(u32x4){PKW(pB1,8),PKW(pB1,10),PKW(pB1,12),PKW(pB1,14)};
    SBAR(); pv(o,(int)(lds0+LDS_V)+((lane>>4)&1)*32+(lane&3)*8+(4*hi+((lane&15)>>2))*64+sl_cur,PAF(0),PAF(1),PAF(2),PAF(3)); }
  #undef PKW
  #undef PAF
  #undef VFR
  #undef PIN
  #undef MX3
  #undef GAPA
  #undef GAPB
  #undef EX
  #undef VRD
  #undef KRD
  #undef STEP
  #undef ENDW
  {auto rr=__builtin_amdgcn_permlane32_swap(__float_as_uint(l_reg),__float_as_uint(l_reg),false,false);l_reg=__uint_as_float(rr[0])+__uint_as_float(rr[1]);}
  if(hi==0)wsf[32+r32]=l_reg;asm volatile("s_waitcnt lgkmcnt(0)":::"memory");
  float rli[16];
  #pragma unroll
  for(int r=0;r<16;++r)rli[r]=__builtin_amdgcn_rcpf(wsf[32+crow(r,hi)]);
  bf16*Ow=O+(rowbase+q0+wid*QBLK)*DM+h*D;
  { bf16*stg=(bf16*)(shm+LDS_OST)+wid*2048;
    #pragma unroll
    for(int r=0;r<16;++r){const int orow=crow(r,hi);
      #pragma unroll
      for(int d0=0;d0<2;++d0)stg[orow*64+d0*32+r32]=__float2bfloat16(o[d0][r]*rli[r]);}
    asm volatile("s_waitcnt lgkmcnt(0)":::"memory");
    #pragma unroll
    for(int i=0;i<4;++i){const int row=i*8+(lane>>3),ch=lane&7; const u32x4 v=*(const u32x4*)(stg+row*64+ch*8); ATTN_STORE16(Ow+(long)row*DM+ch*8,v);} }
  asm volatile("s_waitcnt lgkmcnt(0)\n\ts_barrier":::"memory");
  #undef DMA_K
  #undef BLD
  #undef DMA_V
  #undef CMASK
  #undef START
  #undef RESC
  #undef ROT
}
constexpr int ATTN_LDS_BYTES=LDS_BYTES;
struct AttnTensors { const bf16* Q; const bf16* K; const bf16* V; bf16* O; const float* CL; };
struct AttnUnit { int bh; int qb; };
struct StaticOrder {
  int vcu;
  __device__ __forceinline__ explicit StaticOrder(int grid,int block):vcu((block%8)*(grid/8)+block/8){}
  __device__ __forceinline__ bool next(int i,AttnUnit&u)const{ if(i>=8)return false; const int s=vcu&7,j=i&3; u.bh=(vcu>>3)+32*(i>>2); u.qb=(j==0)?s:(j==1)?15-s:(j==2)?16+s:31-s; return true; }
  __device__ __forceinline__ void a_ready(const AttnUnit&)const{}
  __device__ __forceinline__ void done(const AttnUnit&)const{}
};
template<class Sched,int THRL=8> __device__ __forceinline__ void attn_phase(char*lds,const AttnTensors&T,const Sched&S,int tid0){
  AttnUnit u;
  for(int i=0;S.next(i,u);++i){ S.a_ready(u); attn_unit<THRL>(u.bh/NHEAD,u.bh%NHEAD,u.qb,T.Q,T.K,T.V,T.O,T.CL+(long)u.bh*SEQ,lds,tid0); S.done(u); }
}
#undef SBAR
#undef WAIT_BAR
}
namespace cg = cooperative_groups;
#define LAS __attribute__((address_space(3)))
typedef unsigned short bf16;
typedef unsigned v4u __attribute__((ext_vector_type(4)));
typedef unsigned v2u __attribute__((ext_vector_type(2)));
typedef float f32x4 __attribute__((ext_vector_type(4)));
typedef float f32x16 __attribute__((ext_vector_type(16)));
typedef short bf16x8 __attribute__((ext_vector_type(8)));
typedef short s16x4 __attribute__((ext_vector_type(4)));
typedef float f32x2v __attribute__((ext_vector_type(2)));

constexpr int NWAVES = 8, NTHR = 512;
constexpr int BATCH = 4, SEQ = 8192, D = 1024, M = BATCH * SEQ;
constexpr int DIN = 9232, DFF = 2816, NUP = 2 * DFF;
constexpr float EPS = 1e-6f, LOG2E = 1.4426950408889634f;
constexpr size_t MiB = 1u << 20;
constexpr size_t WS_SS1 = 0, WS_SS2 = 128 * 1024, WS_LBV = 256 * 1024, WS_BAR = 512 * 1024, BAR_BYTES = 16384;
constexpr size_t WS_FLOG = 1 * MiB, WS_CL = 3 * MiB, WS_DK = 5 * MiB;
constexpr size_t WS_WIN = 8 * MiB, WS_WA = 26 * MiB, WS_WB = 28 * MiB, WS_WO = 30 * MiB, WS_WUP = 32 * MiB, WS_WDN = 43 * MiB;
constexpr size_t WS_SLOT0 = 52 * MiB, SLOT = 64 * MiB;
constexpr size_t WS_END = WS_SLOT0 + 7 * SLOT;
constexpr int RING_BYTES = 131072, HALO_OFF = RING_BYTES, MISC_OFF = RING_BYTES + 8192, LDS_BYTES = 151552, BARW_OFF = LDS_BYTES - 64;
constexpr int UP_TM = 254, UP_NM = 130;
static_assert(attn_body::ATTN_LDS_BYTES <= LDS_BYTES, "attention LDS");

#define LDS_WAIT() asm volatile("s_waitcnt lgkmcnt(0)" ::: "memory")
__device__ __forceinline__ unsigned f2bf(float f) { unsigned u = __builtin_bit_cast(unsigned, f); return (u + 0x7fffu + ((u >> 16) & 1u)) >> 16; }
typedef float f32x2_g __attribute__((ext_vector_type(2))); typedef __bf16 bf16x2_g __attribute__((ext_vector_type(2)));
__device__ __forceinline__ unsigned pk2c(float lo, float hi) { const f32x2_g v = {lo, hi}; const bf16x2_g b = __builtin_convertvector(v, bf16x2_g); return __builtin_bit_cast(unsigned, b); }
__device__ __forceinline__ unsigned pk2(float lo, float hi) { return pg8::cvt_pk_bf16(lo, hi); }
__device__ __forceinline__ float bf2f(unsigned short v) { return __builtin_bit_cast(float, (unsigned)v << 16); }
__device__ __forceinline__ float bflo(unsigned w) { return __builtin_bit_cast(float, w << 16); }
__device__ __forceinline__ float bfhi(unsigned w) { return __builtin_bit_cast(float, w & 0xffff0000u); }
__device__ __forceinline__ float wave_sum(float v) {
#pragma unroll
    for (int o = 1; o < 64; o <<= 1) v += __shfl_xor(v, o);
    return v;
}
__device__ __forceinline__ float fexp(float x) { return __builtin_amdgcn_exp2f(x * LOG2E); }
__device__ __forceinline__ float flog(float x) { return __builtin_amdgcn_logf(x) * 0.6931471805599453f; }
__device__ __forceinline__ float fsigmoid(float x) { return __builtin_amdgcn_rcpf(1.0f + fexp(-x)); }
__device__ __forceinline__ float sigp(float gp) { return __builtin_amdgcn_rcpf(1.0f + __builtin_amdgcn_exp2f(gp)); }
__device__ __forceinline__ int crow(int r, int hi) { return (r & 3) + 8 * (r >> 2) + 4 * hi; }

__device__ __forceinline__ void transpose_item(const float* W, int ldw, bf16* WT, int Kd, int k0, int n0, int dst_row0, LAS float* scr, int lane, const float* kscale = nullptr) {
    float tv[32];
#pragma unroll
    for (int i = 0; i < 32; ++i) tv[i] = W[(size_t)(k0 + 2 * i + (lane >> 5)) * ldw + n0 + (lane & 31)];
    if (kscale) {
#pragma unroll
        for (int i = 0; i < 32; ++i) tv[i] *= kscale[k0 + 2 * i + (lane >> 5)]; }
#pragma unroll
    for (int i = 0; i < 32; ++i) scr[(2 * i + (lane >> 5)) * 33 + (lane & 31)] = tv[i];
    LDS_WAIT(); asm volatile("" ::: "memory");
    const int c = lane & 7;
#pragma unroll
    for (int j = 0; j < 4; ++j) { const int n = (lane >> 3) + 8 * j; const LAS float* s = scr + (8 * c) * 33 + n;
        v4u o; o.x = pk2(s[0 * 33], s[1 * 33]); o.y = pk2(s[2 * 33], s[3 * 33]); o.z = pk2(s[4 * 33], s[5 * 33]); o.w = pk2(s[6 * 33], s[7 * 33]);
        *(v4u*)(WT + (size_t)(dst_row0 + n) * Kd + k0 + 8 * c) = o; }
    LDS_WAIT(); asm volatile("" ::: "memory");
}

struct Ptrs {
    const float *x, *norm_mix, *w_in, *fbias, *lblog, *hg_norm, *w_a, *w_b, *w_o, *norm_ffn, *w_up, *conv_w, *conv_b, *w_dn, *norm_final;
    float* out; unsigned char* ws;
};

__device__ __forceinline__ void p0_row(const f32x4 (&vin)[4], int m, const f32x4 (&gm)[4], float fb, const LAS float* wf, bf16* XN, float* FLOG, int lane) {
        f32x4 v[4]; float s2 = 0.f;
#pragma unroll
        for (int j = 0; j < 4; ++j) { v[j] = vin[j]; s2 += (v[j].x * v[j].x + v[j].y * v[j].y) + (v[j].z * v[j].z + v[j].w * v[j].w); }
        const float rstd = 1.0f / sqrtf(wave_sum(s2) * (1.f / D) + EPS);
        unsigned long long* o8 = (unsigned long long*)(XN + (size_t)m * D) + lane;
        float acc[16];
#pragma unroll
        for (int i = 0; i < 16; ++i) acc[i] = 0.f;
#pragma unroll
        for (int j = 0; j < 4; ++j) {
            v[j] = v[j] * rstd * gm[j];
            o8[64 * j] = (unsigned long long)pk2(v[j].x, v[j].y) | ((unsigned long long)pk2(v[j].z, v[j].w) << 32);
#pragma unroll
            for (int e = 0; e < 4; ++e) { const LAS f32x4* wr = (const LAS f32x4*)wf + ((j * 4 + e) * 64 + lane); const float xv = v[j][e];
#pragma unroll
                for (int q = 0; q < 4; ++q) { const f32x4 w = wr[q * 1024]; acc[4 * q] += xv * w.x; acc[4 * q + 1] += xv * w.y; acc[4 * q + 2] += xv * w.z; acc[4 * q + 3] += xv * w.w; } }
        }
        float a8[8], a4[4], a2[2], a1;
        { const bool up = lane & 32;
#pragma unroll
          for (int i = 0; i < 8; ++i) { const float mine = up ? acc[i + 8] : acc[i], oth = up ? acc[i] : acc[i + 8]; a8[i] = mine + __shfl_xor(oth, 32); } }
        { const bool up = lane & 16;
#pragma unroll
          for (int i = 0; i < 4; ++i) { const float mine = up ? a8[i + 4] : a8[i], oth = up ? a8[i] : a8[i + 4]; a4[i] = mine + __shfl_xor(oth, 16); } }
        { const bool up = lane & 8;
#pragma unroll
          for (int i = 0; i < 2; ++i) { const float mine = up ? a4[i + 2] : a4[i], oth = up ? a4[i] : a4[i + 2]; a2[i] = mine + __shfl_xor(oth, 8); } }
        { const bool up = lane & 4; const float mine = up ? a2[1] : a2[0], oth = up ? a2[0] : a2[1]; a1 = mine + __shfl_xor(oth, 4); }
        a1 += __shfl_xor(a1, 2); a1 += __shfl_xor(a1, 1);
        const float z = a1 + fb;
        const float ls = fminf(z, 0.f) - log1pf(expf(-fabsf(z)));
        if ((lane & 3) == 0) FLOG[(size_t)m * 16 + (lane >> 2)] = ls;
}
__device__ __forceinline__ void p0_prologue(LAS unsigned char* lds, const Ptrs& P, int G, int tid0) {
    int tid_ = tid0; asm volatile("" : "+v"(tid_)); const int tid = tid_, lane = tid & 63, wave = tid >> 6;
    const int gw = blockIdx.x * NWAVES + wave, NGW = G * NWAVES;
    unsigned char* ws = P.ws;
    bf16* Wt_in = (bf16*)(ws + WS_WIN);
    {
        LAS float* scr = (LAS float*)(lds + wave * 16384);
        constexpr int I0 = 16 * 224, I1 = 16 * 64, I2 = 16 * 32, I5 = 16 * 176, I6 = 44 * 32;
        constexpr int NIT = I0 + I1 + 3 * I2 + I5 + I6;
        for (int it = gw; it < NIT; it += NGW) {
            int r = it;
            if (r < I0) { const int kb = r / 224, nb = r % 224; transpose_item(P.w_in, DIN, Wt_in, D, 64 * kb, 32 * nb, 32 * nb, scr, lane); continue; } r -= I0;
            if (r < I1) { const int kb = r / 64, nb = r % 64; transpose_item(P.w_in + 7184, DIN, Wt_in, D, 64 * kb, 32 * nb, 7168 + 32 * nb, scr, lane); continue; } r -= I1;
            if (r < I2) { const int kb = r / 32, nb = r % 32; transpose_item(P.w_a, D, (bf16*)(ws + WS_WA), D, 64 * kb, 32 * nb, 32 * nb, scr, lane); continue; } r -= I2;
            if (r < I2) { const int kb = r / 32, nb = r % 32; transpose_item(P.w_b, D, (bf16*)(ws + WS_WB), D, 64 * kb, 32 * nb, 32 * nb, scr, lane); continue; } r -= I2;
            if (r < I2) { const int kb = r / 32, nb = r % 32; transpose_item(P.w_o, D, (bf16*)(ws + WS_WO), D, 64 * kb, 32 * nb, 32 * nb, scr, lane); continue; } r -= I2;
            if (r < I5) { const int kb = r / 176, nb = r % 176; const int n0 = 32 * nb; const int nn = n0 < DFF ? n0 : n0 - DFF;
                const int dst = 256 * (nn / 128) + (nn % 128) + (n0 < DFF ? 0 : 128);
                transpose_item(P.w_up, NUP, (bf16*)(ws + WS_WUP), D, 64 * kb, n0, dst, scr, lane, P.norm_ffn); continue; } r -= I5;
            { const int kb = r / 32, nb = r % 32; transpose_item(P.w_dn, D, (bf16*)(ws + WS_WDN), DFF, 64 * kb, 32 * nb, 32 * nb, scr, lane); }
        }
    }
    { float* ss = (float*)(ws + WS_SS1); for (int i = blockIdx.x * NTHR + tid; i < 2 * M; i += G * NTHR) ss[i] = 0.f; }
    if (blockIdx.x == 0) { float* lbv = (float*)(ws + WS_LBV); for (int k = tid; k < 1024; k += NTHR) lbv[k] = fsigmoid(P.lblog[k] - P.lblog[1024 + k]); }
    __syncthreads();
    LAS float* wf = (LAS float*)lds;
    for (int i = tid; i < 1024 * 16; i += NTHR) { const int k = i >> 4, h = i & 15; const int kp = ((k >> 8) * 4 + (k & 3)) * 64 + ((k >> 2) & 63);
        wf[(((h >> 2) * 1024 + kp) << 2) + (h & 3)] = P.w_in[(size_t)k * DIN + 7168 + h]; }
    __syncthreads();
    f32x4 gm[4];
#pragma unroll
    for (int j = 0; j < 4; ++j) gm[j] = ((const f32x4*)P.norm_mix)[lane + 64 * j];
    const float fb = P.fbias[(lane >> 2) & 15];
    bf16* XN = (bf16*)(ws + WS_SLOT0);
    float* FLOG = (float*)(ws + WS_FLOG);
    f32x4 r0[4], r1[4], r2[4], r3[4];
#define P0_LOAD(r, mm) do { if ((mm) < M) { const f32x4* xr_ = (const f32x4*)(P.x + (size_t)(mm) * D) + lane; _Pragma("unroll") for (int j = 0; j < 4; ++j) r[j] = xr_[64 * j]; } } while (0)
#define P0_ROW(r, mm) do { if ((mm) < M) p0_row(r, (mm), gm, fb, wf, XN, FLOG, lane); } while (0)
    P0_LOAD(r0, gw); P0_LOAD(r1, gw + NGW); P0_LOAD(r2, gw + 2 * NGW);
    for (int m = gw; m < M; m += 4 * NGW) {
        P0_LOAD(r3, m + 3 * NGW); P0_ROW(r0, m);
        P0_LOAD(r0, m + 4 * NGW); P0_ROW(r1, m + NGW);
        P0_LOAD(r1, m + 5 * NGW); P0_ROW(r2, m + 2 * NGW);
        P0_LOAD(r2, m + 6 * NGW); P0_ROW(r3, m + 3 * NGW);
    }
#undef P0_LOAD
#undef P0_ROW
}

__device__ __forceinline__ void p1_cscan(LAS unsigned char* lds, const Ptrs& P, int tid0) {
    if (blockIdx.x >= 64) return;
    int tid_ = tid0; asm volatile("" : "+v"(tid_)); const int tid = tid_, lane = tid & 63, wave = tid >> 6;
    const int s = blockIdx.x, b = s >> 4, h = s & 15;
    const float* fl = (const float*)(P.ws + WS_FLOG) + (size_t)b * SEQ * 16 + h;
    float v[16]; float run = 0.f;
#pragma unroll
    for (int j = 0; j < 16; ++j) { run += fl[(size_t)(16 * tid + j) * 16]; v[j] = run; }
    float tot = run;
#pragma unroll
    for (int o = 1; o < 64; o <<= 1) { const float t = __shfl_up(tot, o); if (lane >= o) tot += t; }
    LAS float* wsum = (LAS float*)(lds + MISC_OFF);
    if (lane == 63) wsum[wave] = tot;
    __syncthreads();
    float base = 0.f;
#pragma unroll
    for (int w = 0; w < 8; ++w) if (w < wave) base += wsum[w];
    const float pre = base + tot - run;
    float* cl = (float*)(P.ws + WS_CL) + (size_t)s * SEQ + 16 * tid;
#pragma unroll
    for (int j = 0; j < 16; ++j) cl[j] = (pre + v[j]) * LOG2E;
    __syncthreads();
}

using pg8::Unit; using pg8::HALF; using pg8::BM;
struct EpiProj {
    static constexpr bool PERM = true, AFTER_DRAIN = false;
    bf16 *o0, *o1, *o2, *o3; int m0, m1, m2, m3; float scale0; const float* lbv; float scale1;
    __device__ __forceinline__ void operator()(const f32x4 (&acc)[2][2][4][2], const Unit& u, int wr, int wc, int fr, int fq) const {
        const int colt = u.pn * BM, seg = colt >> 10, colin = colt & 1023;
        bf16* base = (bf16*)((uintptr_t)(seg == 0) * (uintptr_t)o0 + (uintptr_t)(seg == 1) * (uintptr_t)o1 + (uintptr_t)(seg == 2) * (uintptr_t)o2 + (uintptr_t)(seg == 3) * (uintptr_t)o3);
        const int mode = (seg == 0) * m0 + (seg == 1) * m1 + (seg == 2) * m2 + (seg == 3) * m3;
        const float sc = seg == 0 ? scale0 : scale1;
        const int row0 = u.pm * BM + wr * 64 + fr, col0 = colin + wc * 32 + 8 * fq;
#pragma unroll
        for (int ai = 0; ai < 2; ++ai)
#pragma unroll
            for (int m = 0; m < 4; ++m) { bf16* rowp = base + (size_t)(row0 + ai * HALF + m * 16) * D + col0;
#pragma unroll
                for (int bj = 0; bj < 2; ++bj) { const f32x4 a0 = acc[ai][bj][m][0], a1 = acc[ai][bj][m][1];
                    float r[8] = {a0[0], a0[1], a0[2], a0[3], a1[0], a1[1], a1[2], a1[3]};
                    if (mode == 0) {
#pragma unroll
                        for (int q = 0; q < 8; ++q) r[q] *= sc;
                    } else if (mode == 1) {
#pragma unroll
                        for (int q = 0; q < 8; ++q) r[q] = r[q] * fsigmoid(r[q]);
                    } else {
                        const f32x4 l0 = *(const f32x4*)(lbv + col0 + bj * HALF), l1 = *(const f32x4*)(lbv + col0 + bj * HALF + 4);
                        const float l8[8] = {l0[0], l0[1], l0[2], l0[3], l1[0], l1[1], l1[2], l1[3]};
#pragma unroll
                        for (int q = 0; q < 8; ++q) r[q] = flog(l8[q] + (1.f - l8[q]) * fsigmoid(r[q]));
                    }
                    v4u w; w.x = pk2(r[0], r[1]); w.y = pk2(r[2], r[3]); w.z = pk2(r[4], r[5]); w.w = pk2(r[6], r[7]);
                    *(v4u*)(rowp + bj * HALF) = w; } }
    }
};
struct EpiGate {
    static constexpr bool PERM = true, AFTER_DRAIN = false;
    const bf16* gate; const bf16* add; bf16* out;
    __device__ __forceinline__ void operator()(const f32x4 (&acc)[2][2][4][2], const Unit& u, int wr, int wc, int fr, int fq) const {
        const int row0 = u.pm * BM + wr * 64 + fr, col0 = u.pn * BM + wc * 32 + 8 * fq;
#pragma unroll
        for (int ai = 0; ai < 2; ++ai)
#pragma unroll
            for (int m = 0; m < 4; ++m) { const size_t off = (size_t)(row0 + ai * HALF + m * 16) * D + col0;
#pragma unroll
                for (int bj = 0; bj < 2; ++bj) {
                    const v4u g = *(const v4u*)(gate + off + bj * HALF);
                    v4u a = (v4u){0u, 0u, 0u, 0u}; if (add) a = *(const v4u*)(add + off + bj * HALF);
                    const f32x4 v0 = acc[ai][bj][m][0], v1 = acc[ai][bj][m][1];
                    float r[8];
                    r[0] = bflo(a.x) + sigp(bflo(g.x)) * v0[0]; r[1] = bfhi(a.x) + sigp(bfhi(g.x)) * v0[1];
                    r[2] = bflo(a.y) + sigp(bflo(g.y)) * v0[2]; r[3] = bfhi(a.y) + sigp(bfhi(g.y)) * v0[3];
                    r[4] = bflo(a.z) + sigp(bflo(g.z)) * v1[0]; r[5] = bfhi(a.z) + sigp(bfhi(g.z)) * v1[1];
                    r[6] = bflo(a.w) + sigp(bflo(g.w)) * v1[2]; r[7] = bfhi(a.w) + sigp(bfhi(g.w)) * v1[3];
                    v4u w; w.x = pk2(r[0], r[1]); w.y = pk2(r[2], r[3]); w.z = pk2(r[4], r[5]); w.w = pk2(r[6], r[7]);
                    *(v4u*)(out + off + bj * HALF) = w; }
                if (m & 1) asm volatile("" ::: "memory"); }
    }
};
struct EpiRes {
    static constexpr bool PERM = false, AFTER_DRAIN = false;
    const float* base; float* out; bf16* xh; const float* gcol; float* ss;
    __device__ __forceinline__ void operator()(const f32x4 (&acc)[2][2][4][2], const Unit& u, int wr, int wc, int fr, int fq) const {
        const int col0 = u.pn * BM + wc * 32 + 4 * fq;
        f32x4 gv[2][2];
#pragma unroll
        for (int bj = 0; bj < 2; ++bj)
#pragma unroll
            for (int n = 0; n < 2; ++n) gv[bj][n] = xh ? *(const f32x4*)(gcol + col0 + bj * HALF + n * 16) : (f32x4){0.f, 0.f, 0.f, 0.f};
#pragma unroll
        for (int ai = 0; ai < 2; ++ai)
#pragma unroll
            for (int m = 0; m < 4; ++m) { const int row = u.pm * BM + ai * HALF + wr * 64 + m * 16 + fr; const size_t off = (size_t)row * D + col0; float s = 0.f;
#pragma unroll
                for (int bj = 0; bj < 2; ++bj)
#pragma unroll
                    for (int n = 0; n < 2; ++n) { const f32x4 h = *(const f32x4*)(base + off + bj * HALF + n * 16) + acc[ai][bj][m][n];
                        *(f32x4*)(out + off + bj * HALF + n * 16) = h; s += (h[0] * h[0] + h[1] * h[1]) + (h[2] * h[2] + h[3] * h[3]);
                        if (xh) { const f32x4 g = h * gv[bj][n]; v2u w; w.x = pk2(g[0], g[1]); w.y = pk2(g[2], g[3]); *(v2u*)(xh + off + bj * HALF + n * 16) = w; } }
                s += __shfl_xor(s, 16); s += __shfl_xor(s, 32);
                if (fq == 0) atomicAdd(ss + row, s);
                asm volatile("" ::: "memory"); }
    }
};
struct EpiResB {
    static constexpr bool PERM = true, AFTER_DRAIN = false;
    const float* basef; const bf16* baseb; bf16* outb; float* ss;
    __device__ __forceinline__ void operator()(const f32x4 (&acc)[2][2][4][2], const Unit& u, int wr, int wc, int fr, int fq) const {
        const int col0 = u.pn * BM + wc * 32 + 8 * fq;
#pragma unroll
        for (int ai = 0; ai < 2; ++ai)
#pragma unroll
            for (int m = 0; m < 4; ++m) { const int row = u.pm * BM + ai * HALF + wr * 64 + m * 16 + fr; const size_t off = (size_t)row * D + col0; float s = 0.f;
#pragma unroll
                for (int bj = 0; bj < 2; ++bj) {
                    f32x4 b0, b1;
                    if (basef) { b0 = *(const f32x4*)(basef + off + bj * HALF); b1 = *(const f32x4*)(basef + off + bj * HALF + 4); }
                    else { const v4u w = *(const v4u*)(baseb + off + bj * HALF); b0 = (f32x4){bflo(w.x), bfhi(w.x), bflo(w.y), bfhi(w.y)}; b1 = (f32x4){bflo(w.z), bfhi(w.z), bflo(w.w), bfhi(w.w)}; }
                    const f32x4 h0 = b0 + acc[ai][bj][m][0], h1 = b1 + acc[ai][bj][m][1];
                    s += ((h0[0] * h0[0] + h0[1] * h0[1]) + (h0[2] * h0[2] + h0[3] * h0[3])) + ((h1[0] * h1[0] + h1[1] * h1[1]) + (h1[2] * h1[2] + h1[3] * h1[3]));
                    v4u o; o.x = pk2(h0[0], h0[1]); o.y = pk2(h0[2], h0[3]); o.z = pk2(h1[0], h1[1]); o.w = pk2(h1[2], h1[3]);
                    *(v4u*)(outb + off + bj * HALF) = o; }
                s += __shfl_xor(s, 16); s += __shfl_xor(s, 32);
                if (fq == 0) atomicAdd(ss + row, s);
                if (m & 1) asm volatile("" ::: "memory"); }
    }
};
#define DPP_ROR1 0x121
#define DPP_ROR2 0x122
#define DPP_SHR1 0x111
#define DPP_SHR2 0x112
template <int CTRL> __device__ __forceinline__ float dppf(float old, float src) {
    return __builtin_bit_cast(float, __builtin_amdgcn_update_dpp(__builtin_bit_cast(int, old), __builtin_bit_cast(int, src), CTRL, 0xf, 0xf, false));
}
struct EpiConvGlu {
    static constexpr bool PERM = true, AFTER_DRAIN = false, PERMA = true;
    bf16* hm; const float* ss1; const float* conv_w; const float* conv_b; LAS unsigned char* halo; float* ub;
    __device__ __forceinline__ void operator()(const f32x4 (&acc)[2][2][4][2], const Unit& u, int wr, int wc, int fr, int fq) const {
        LAS f32x4* H = (LAS f32x4*)halo;
        const int grow0 = BM * u.pm + wr * 64 + 4 * fr;
        float rs[2][4];
#pragma unroll
        for (int ai = 0; ai < 2; ++ai) { const f32x4 sv = *(const f32x4*)(ss1 + grow0 + ai * HALF);
#pragma unroll
            for (int m = 0; m < 4; ++m) rs[ai][m] = __builtin_amdgcn_rsqf(sv[m] * (1.f / D) + EPS); }
        if (fr == 15) {
#pragma unroll
            for (int ai = 0; ai < 2; ++ai)
#pragma unroll
                for (int bj = 0; bj < 2; ++bj)
#pragma unroll
                    for (int n = 0; n < 2; ++n)
#pragma unroll
                        for (int mm = 0; mm < 2; ++mm) H[((((ai * 2 + wr) * 2 + mm) * 4 + wc) * 4 + fq) * 4 + bj * 2 + n] = acc[ai][bj][2 + mm][n] * rs[ai][2 + mm];
        }
        { const int ucol = u.pn * BM + wc * 32 + 8 * fq;
          if (wr == 0 && fr == 0) {
#pragma unroll
              for (int bj = 0; bj < 2; ++bj)
#pragma unroll
                  for (int n = 0; n < 2; ++n)
#pragma unroll
                      for (int mm = 0; mm < 2; ++mm) *(f32x4*)(ub + ((size_t)u.pm * 4 + mm) * NUP + ucol + bj * HALF + 4 * n) = acc[0][bj][mm][n] * rs[0][mm]; }
          if (wr == 1 && fr == 15) {
#pragma unroll
              for (int bj = 0; bj < 2; ++bj)
#pragma unroll
                  for (int n = 0; n < 2; ++n)
#pragma unroll
                      for (int mm = 0; mm < 2; ++mm) *(f32x4*)(ub + ((size_t)u.pm * 4 + 2 + mm) * NUP + ucol + bj * HALF + 4 * n) = acc[1][bj][2 + mm][n] * rs[1][2 + mm]; } }
        const int gc0 = u.pn * 128 + wc * 32 + 8 * fq;
        f32x4 w0[2], w1[2], w2[2], cb[2];
#pragma unroll
        for (int bj = 0; bj < 2; ++bj) { const int c = gc0 + bj * DFF; w0[bj] = *(const f32x4*)(conv_w + c); w1[bj] = *(const f32x4*)(conv_w + NUP + c); w2[bj] = *(const f32x4*)(conv_w + 2 * NUP + c); cb[bj] = *(const f32x4*)(conv_b + c); }
        asm volatile("s_waitcnt lgkmcnt(0)\n\ts_barrier" ::: "memory");
        f32x4 w0b[2], w1b[2], w2b[2], cbb[2];
        v2u wsave[2][4];
#pragma unroll
        for (int n = 0; n < 2; ++n) {
            const int gc = gc0 + 4 * n;
            if (n == 1) {
#pragma unroll
                for (int bj = 0; bj < 2; ++bj) { w0[bj] = w0b[bj]; w1[bj] = w1b[bj]; w2[bj] = w2b[bj]; cb[bj] = cbb[bj]; }
            }
#pragma unroll
            for (int ai = 0; ai < 2; ++ai) {
                const int blk = ai * 2 + wr;
                if (n == 0 && ai == 1) {
#pragma unroll
                    for (int bj = 0; bj < 2; ++bj) { const int c = gc0 + 4 + bj * DFF; w0b[bj] = *(const f32x4*)(conv_w + c); w1b[bj] = *(const f32x4*)(conv_w + NUP + c); w2b[bj] = *(const f32x4*)(conv_w + 2 * NUP + c); cbb[bj] = *(const f32x4*)(conv_b + c); }
                }
                f32x4 y[2][4];
#pragma unroll
                for (int bj = 0; bj < 2; ++bj) {
                    f32x4 o0 = (f32x4){0.f, 0.f, 0.f, 0.f}, o1 = o0;
                    if (blk > 0) { o0 = H[(((((blk - 1) * 2 + 0) * 4 + wc) * 4 + fq) * 4) + bj * 2 + n]; o1 = H[(((((blk - 1) * 2 + 1) * 4 + wc) * 4 + fq) * 4) + bj * 2 + n]; }
                    const f32x4 x0 = acc[ai][bj][0][n] * rs[ai][0], x1 = acc[ai][bj][1][n] * rs[ai][1], x2 = acc[ai][bj][2][n] * rs[ai][2], x3 = acc[ai][bj][3][n] * rs[ai][3];
                    f32x4 xm1, xm2;
#pragma unroll
                    for (int e = 0; e < 4; ++e) { xm1[e] = dppf<DPP_SHR1>(o1[e], x3[e]); xm2[e] = dppf<DPP_SHR1>(o0[e], x2[e]); }
                    y[bj][0] = cb[bj] + w2[bj] * x0 + w1[bj] * xm1 + w0[bj] * xm2;
                    y[bj][1] = cb[bj] + w2[bj] * x1 + w1[bj] * x0 + w0[bj] * xm1;
                    y[bj][2] = cb[bj] + w2[bj] * x2 + w1[bj] * x1 + w0[bj] * x0;
                    y[bj][3] = cb[bj] + w2[bj] * x3 + w1[bj] * x2 + w0[bj] * x1;
                }
#pragma unroll
                for (int m = 0; m < 4; ++m) {
                    const int grow = grow0 + ai * HALF + m;
                    const pg8::f32x2 ga = pg8::gelu_pk((pg8::f32x2){y[0][m][0], y[0][m][1]}), gb = pg8::gelu_pk((pg8::f32x2){y[0][m][2], y[0][m][3]});
                    v2u w; w.x = pk2(ga.x * y[1][m][0], ga.y * y[1][m][1]); w.y = pk2(gb.x * y[1][m][2], gb.y * y[1][m][3]);
                    if (n == 0) wsave[ai][m] = w; else { const v4u o = (v4u){wsave[ai][m].x, wsave[ai][m].y, w.x, w.y}; *(v4u*)(hm + (size_t)grow * DFF + gc0) = o; }
                }
            }
        }
    }
};
__device__ __forceinline__ void up_fixup(const float* ub, const float* conv_w, const float* conv_b, bf16* hm, int G, int tid0) {
    int tid_ = tid0; asm volatile("" : "+v"(tid_));
    for (int idx = blockIdx.x * NTHR + tid_; idx < 128 * 2 * DFF; idx += G * NTHR) {
        const int gc = idx % DFF, rr = (idx / DFF) & 1, pm = idx / (2 * DFF);
        if ((pm & 31) == 0) continue;
        const int ig = (gc >> 7) * 256 + (gc & 127);
        float y[2];
#pragma unroll
        for (int sd = 0; sd < 2; ++sd) {
            const int col = ig + sd * 128, c = gc + sd * DFF;
            const float um2 = ub[((size_t)(pm - 1) * 4 + 2) * NUP + col], um1 = ub[((size_t)(pm - 1) * 4 + 3) * NUP + col], u0 = ub[((size_t)pm * 4 + 0) * NUP + col], u1 = ub[((size_t)pm * 4 + 1) * NUP + col];
            const float w0 = conv_w[c], w1 = conv_w[NUP + c], w2 = conv_w[2 * NUP + c];
            y[sd] = conv_b[c] + (rr == 0 ? (w2 * u0 + w1 * um1 + w0 * um2) : (w2 * u1 + w1 * u0 + w0 * um1));
        }
        const float gl = 0.5f * y[0] * (1.0f + erff(y[0] * 0.70710678118654752f));
        hm[(size_t)(BM * pm + rr) * DFF + gc] = (bf16)f2bf(gl * y[1]);
    }
}

#define LBAR() asm volatile("s_waitcnt lgkmcnt(0)\n\ts_barrier" ::: "memory")
__device__ __forceinline__ void hgrn_tile_load(const bf16* T, int u, int tid, v4u (&r)[2]) {
    const int bh = u >> 7, c = u & 127, b = bh >> 3, h = bh & 7;
    const bf16* base = T + ((size_t)b * SEQ + c * 64) * D + h * 128;
#pragma unroll
    for (int j = 0; j < 2; ++j) { const int p = tid + 512 * j; r[j] = *(const v4u*)(base + (size_t)(p >> 4) * D + (p & 15) * 8); }
}
__device__ __forceinline__ void hgrn_tile_stage(LAS bf16* R, int tid, const v4u (&r)[2]) {
#pragma unroll
    for (int j = 0; j < 2; ++j) { const int p = tid + 512 * j; *(LAS v4u*)(R + (p >> 4) * 136 + (p & 15) * 8) = r[j]; }
}
__device__ __forceinline__ void hgrn_block_read(const LAS bf16* R, int kp, int part, unsigned (&w)[8]) {
#pragma unroll
    for (int j = 0; j < 8; ++j) w[j] = *(const LAS unsigned*)(R + (8 * part + j) * 136 + 2 * kp);
}
__device__ __forceinline__ void hgrn_vt_store2(const unsigned (&w)[8], LAS bf16* VT, int kp, int part) {
    v4u lo, hi;
    lo.x = (w[0] & 0xffffu) | (w[1] << 16); lo.y = (w[2] & 0xffffu) | (w[3] << 16); lo.z = (w[4] & 0xffffu) | (w[5] << 16); lo.w = (w[6] & 0xffffu) | (w[7] << 16);
    hi.x = (w[0] >> 16) | (w[1] & 0xffff0000u); hi.y = (w[2] >> 16) | (w[3] & 0xffff0000u); hi.z = (w[4] >> 16) | (w[5] & 0xffff0000u); hi.w = (w[6] >> 16) | (w[7] & 0xffff0000u);
    *(LAS v4u*)(VT + (2 * kp) * 72 + 8 * part) = lo; *(LAS v4u*)(VT + (2 * kp + 1) * 72 + 8 * part) = hi;
}
__device__ __forceinline__ void hgrn_pass_a(LAS unsigned char* lds, const bf16* HLF, const bf16* HI, bf16* LS, float* DK, int G, int tid0) {
    int tid_ = tid0; asm volatile("" : "+v"(tid_)); const int tid = tid_, lane = tid & 63, wave = tid >> 6, kp = lane, part = wave;
    LAS bf16* KT = (LAS bf16*)lds;
    LAS bf16* VT = (LAS bf16*)(lds + 18432);
    LAS float* SM = (LAS float*)(lds + 36864);
    LAS bf16* RF = (LAS bf16*)(lds + 40960);
    LAS bf16* RV = (LAS bf16*)(lds + 58368);
    v4u rf[2], rv[2];
    if ((int)blockIdx.x < 4096) { hgrn_tile_load(HLF, blockIdx.x, tid, rf); hgrn_tile_load(HI, blockIdx.x, tid, rv); }
    for (int u = blockIdx.x; u < 4096; u += G) {
        hgrn_tile_stage(RF, tid, rf); hgrn_tile_stage(RV, tid, rv);
        if (u + G < 4096) { hgrn_tile_load(HLF, u + G, tid, rf); hgrn_tile_load(HI, u + G, tid, rv); }
        LBAR();
        unsigned wf[8], wv[8];
        hgrn_block_read(RF, kp, part, wf); hgrn_block_read(RV, kp, part, wv);
        float l0[8], l1[8], b0[8], b1[8]; float r0 = 0.f, r1 = 0.f;
#pragma unroll
        for (int j = 0; j < 8; ++j) { l0[j] = bflo(wf[j]); l1[j] = bfhi(wf[j]); r0 += l0[j]; r1 += l1[j]; b0[j] = r0; b1[j] = r1; }
        *(LAS f32x2v*)(SM + part * 128 + 2 * kp) = (f32x2v){r0, r1};
        hgrn_vt_store2(wv, VT, kp, part);
        LBAR();
        float t0 = 0.f, t1 = 0.f, p0 = 0.f, p1 = 0.f;
#pragma unroll
        for (int p = 0; p < 8; ++p) { const f32x2v sp = *(const LAS f32x2v*)(SM + p * 128 + 2 * kp); t0 += sp.x; t1 += sp.y; if (p < part) { p0 += sp.x; p1 += sp.y; } }
        unsigned k0w[4], k1w[4];
#pragma unroll
        for (int j = 0; j < 8; j += 2) {
            k0w[j >> 1] = pk2((1.f - fexp(l0[j])) * fexp(t0 - (p0 + b0[j])), (1.f - fexp(l0[j + 1])) * fexp(t0 - (p0 + b0[j + 1])));
            k1w[j >> 1] = pk2((1.f - fexp(l1[j])) * fexp(t1 - (p1 + b1[j])), (1.f - fexp(l1[j + 1])) * fexp(t1 - (p1 + b1[j + 1])));
        }
        *(LAS v4u*)(KT + (2 * kp) * 72 + 8 * part) = (v4u){k0w[0], k0w[1], k0w[2], k0w[3]}; *(LAS v4u*)(KT + (2 * kp + 1) * 72 + 8 * part) = (v4u){k1w[0], k1w[1], k1w[2], k1w[3]};
        if (part == 0) *(f32x2v*)(DK + (size_t)u * 128 + 2 * kp) = (f32x2v){fexp(t0), fexp(t1)};
        LBAR();
        const int r = lane & 31, hh = lane >> 5, vi = wave >> 1;
#pragma unroll
        for (int q = 0; q < 2; ++q) {
            const int kj = 2 * (wave & 1) + q; f32x16 acc = {};
#pragma unroll
            for (int ks = 0; ks < 4; ++ks) {
                const bf16x8 a = *(const LAS bf16x8*)(KT + (32 * kj + r) * 72 + 16 * ks + 8 * hh);
                const bf16x8 bb = *(const LAS bf16x8*)(VT + (32 * vi + r) * 72 + 16 * ks + 8 * hh);
                acc = __builtin_amdgcn_mfma_f32_32x32x16_bf16(a, bb, acc, 0, 0, 0);
            }
            bf16* dst = LS + (size_t)u * 16384 + (size_t)(32 * vi + r) * 128 + 32 * kj + 4 * hh;
#pragma unroll
            for (int g = 0; g < 4; ++g) { v2u w; w.x = pk2c(acc[4 * g], acc[4 * g + 1]); w.y = pk2c(acc[4 * g + 2], acc[4 * g + 3]); *(v2u*)(dst + 8 * g) = w; }
        }
        LBAR();
    }
}
__device__ __forceinline__ void hgrn_pass_b(unsigned* LS32, const float* DK, int G, int tid0) {
    int tid_ = tid0; asm volatile("" : "+v"(tid_)); const int gt = blockIdx.x * NTHR + tid_, NG = G * NTHR;
    for (int p = gt; p < 32 * 8192; p += NG) {
        const int bh = p >> 13, e2 = p & 8191, k = 2 * (e2 & 63);
        unsigned* ls = LS32 + (size_t)bh * 128 * 8192 + e2;
        const float* dk = DK + (size_t)bh * 128 * 128 + k;
        float s0 = 0.f, s1 = 0.f;
        for (int c0 = 0; c0 < 128; c0 += 8) {
            unsigned w[8]; float d0[8], d1[8];
#pragma unroll
            for (int i = 0; i < 8; ++i) { w[i] = ls[(size_t)(c0 + i) * 8192]; const float2 d = *(const float2*)(dk + (size_t)(c0 + i) * 128); d0[i] = d.x; d1[i] = d.y; }
#pragma unroll
            for (int i = 0; i < 8; ++i) { ls[(size_t)(c0 + i) * 8192] = pk2(s0, s1); s0 = d0[i] * s0 + bflo(w[i]); s1 = d1[i] * s1 + bfhi(w[i]); }
        }
    }
}
__device__ __forceinline__ void hgrn_pass_c(LAS unsigned char* lds, bf16* HQ, const bf16* HLF, const bf16* HI, const bf16* HG, const bf16* LS, const float* gnorm, int G, int tid0) {
    int tid_ = tid0; asm volatile("" : "+v"(tid_)); const int tid = tid_, lane = tid & 63, wave = tid >> 6, kp = lane, part = wave;
    LAS bf16* QT = (LAS bf16*)lds;
    LAS bf16* KT2 = (LAS bf16*)(lds + 17408);
    LAS bf16* VT = (LAS bf16*)(lds + 34816);
    LAS float* SM = (LAS float*)(lds + 53248);
    LAS bf16* RF = (LAS bf16*)(lds + 57344);
    LAS bf16* RQ = (LAS bf16*)(lds + 74752);
    LAS bf16* RV = (LAS bf16*)(lds + 92160);
    LAS float* OL = (LAS float*)(lds + 57344);
    const int r = lane & 31, hh = lane >> 5, ti = wave & 1, vj = wave >> 1;
    v4u rf[2], rq[2], rv[2];
    if ((int)blockIdx.x < 4096) { hgrn_tile_load(HLF, blockIdx.x, tid, rf); hgrn_tile_load(HQ, blockIdx.x, tid, rq); hgrn_tile_load(HI, blockIdx.x, tid, rv); }
    for (int u = blockIdx.x; u < 4096; u += G) {
        const int bh = u >> 7, c = u & 127, b = bh >> 3, h = bh & 7;
        const size_t row0 = (size_t)b * SEQ + c * 64;
        hgrn_tile_stage(RF, tid, rf); hgrn_tile_stage(RQ, tid, rq); hgrn_tile_stage(RV, tid, rv);
        bf16x8 sfr[8];
        { const bf16* Sg = LS + (size_t)u * 16384 + (size_t)(32 * vj + r) * 128 + 8 * hh;
#pragma unroll
          for (int ks = 0; ks < 8; ++ks) sfr[ks] = *(const bf16x8*)(Sg + 16 * ks); }
        const size_t goff = (row0 + (tid >> 3)) * D + h * 128 + 16 * (tid & 7);
        const v4u g0 = *(const v4u*)(HG + goff), g1 = *(const v4u*)(HG + goff + 8);
        if (u + G < 4096) { hgrn_tile_load(HLF, u + G, tid, rf); hgrn_tile_load(HQ, u + G, tid, rq); hgrn_tile_load(HI, u + G, tid, rv); }
        LBAR();
        unsigned wf[8], wq[8];
        { unsigned wv[8]; hgrn_block_read(RV, kp, part, wv); hgrn_vt_store2(wv, VT, kp, part); }
        hgrn_block_read(RF, kp, part, wf); hgrn_block_read(RQ, kp, part, wq);
        float l0[8], l1[8], b0[8], b1[8]; float r0 = 0.f, r1 = 0.f;
#pragma unroll
        for (int j = 0; j < 8; ++j) { l0[j] = bflo(wf[j]); l1[j] = bfhi(wf[j]); r0 += l0[j]; r1 += l1[j]; b0[j] = r0; b1[j] = r1; }
        *(LAS f32x2v*)(SM + part * 128 + 2 * kp) = (f32x2v){r0, r1};
        LBAR();
        float p0 = 0.f, p1 = 0.f;
#pragma unroll
        for (int p = 0; p < 7; ++p) { const f32x2v sp = *(const LAS f32x2v*)(SM + p * 128 + 2 * kp); if (p < part) { p0 += sp.x; p1 += sp.y; } }
#pragma unroll
        for (int j = 0; j < 8; ++j) {
            const float bb0 = p0 + b0[j], bb1 = p1 + b1[j];
            *(LAS unsigned*)(QT + (8 * part + j) * 136 + 2 * kp) = pk2(bflo(wq[j]) * fexp(bb0), bfhi(wq[j]) * fexp(bb1));
            *(LAS unsigned*)(KT2 + (8 * part + j) * 136 + 2 * kp) = pk2((1.f - fexp(l0[j])) * fexp(-bb0), (1.f - fexp(l1[j])) * fexp(-bb1));
        }
        LBAR();
        bf16x8 pa[2][2];
#pragma unroll
        for (int sj = 0; sj < 2; ++sj) { pa[sj][0] = (bf16x8){0, 0, 0, 0, 0, 0, 0, 0}; pa[sj][1] = pa[sj][0]; }
#pragma unroll
        for (int sj = 0; sj < 2; ++sj) {
            if (sj <= ti) {
                f32x16 x = {};
#pragma unroll
                for (int ks = 0; ks < 8; ++ks) {
                    const bf16x8 a = *(const LAS bf16x8*)(KT2 + (32 * sj + r) * 136 + 16 * ks + 8 * hh);
                    const bf16x8 bq = *(const LAS bf16x8*)(QT + (32 * ti + r) * 136 + 16 * ks + 8 * hh);
                    x = __builtin_amdgcn_mfma_f32_32x32x16_bf16(a, bq, x, 0, 0, 0);
                }
                if (sj == ti) {
#pragma unroll
                    for (int i = 0; i < 16; ++i) if (crow(i, hh) > r) x[i] = 0.f;
                }
#pragma unroll
                for (int s2 = 0; s2 < 2; ++s2) { v4u pw; pw.x = pk2c(x[8 * s2], x[8 * s2 + 1]); pw.y = pk2c(x[8 * s2 + 2], x[8 * s2 + 3]); pw.z = pk2c(x[8 * s2 + 4], x[8 * s2 + 5]); pw.w = pk2c(x[8 * s2 + 6], x[8 * s2 + 7]);
                    pa[sj][s2] = __builtin_bit_cast(bf16x8, pw); }
            }
        }
        f32x16 o = {};
#pragma unroll
        for (int ks = 0; ks < 8; ++ks) {
            const bf16x8 a = *(const LAS bf16x8*)(QT + (32 * ti + r) * 136 + 16 * ks + 8 * hh);
            o = __builtin_amdgcn_mfma_f32_32x32x16_bf16(a, sfr[ks], o, 0, 0, 0);
        }
#pragma unroll
        for (int sj = 0; sj < 2; ++sj) {
            if (sj <= ti) {
#pragma unroll
                for (int s2 = 0; s2 < 2; ++s2) {
                    const LAS bf16* vp = VT + (32 * vj + r) * 72 + 32 * sj + 16 * s2 + 4 * hh;
                    const s16x4 lo = *(const LAS s16x4*)vp, hi4 = *(const LAS s16x4*)(vp + 8);
                    const bf16x8 pb = (bf16x8){lo[0], lo[1], lo[2], lo[3], hi4[0], hi4[1], hi4[2], hi4[3]};
                    o = __builtin_amdgcn_mfma_f32_32x32x16_bf16(pa[sj][s2], pb, o, 0, 0, 0);
                }
            }
        }
#pragma unroll
        for (int i = 0; i < 16; ++i) OL[(32 * ti + crow(i, hh)) * 132 + 32 * vj + r] = o[i];
        LBAR();
        {
            const int t = tid >> 3, vp = tid & 7;
            f32x4 ov[4]; float ss = 0.f;
#pragma unroll
            for (int q = 0; q < 4; ++q) { ov[q] = *(const LAS f32x4*)(OL + t * 132 + 16 * vp + 4 * q); ss += (ov[q][0] * ov[q][0] + ov[q][1] * ov[q][1]) + (ov[q][2] * ov[q][2] + ov[q][3] * ov[q][3]); }
            ss += __shfl_xor(ss, 1); ss += __shfl_xor(ss, 2); ss += __shfl_xor(ss, 4);
            const float rstd = 1.0f / sqrtf(ss * (1.f / 128.f) + EPS);
            const size_t off = goff;
            const f32x4* gn = (const f32x4*)(gnorm + 16 * vp);
            const f32x4 n0 = gn[0], n1 = gn[1], n2 = gn[2], n3 = gn[3];
            v4u w0, w1;
            w0.x = pk2(ov[0][0] * rstd * n0[0] * bflo(g0.x), ov[0][1] * rstd * n0[1] * bfhi(g0.x)); w0.y = pk2(ov[0][2] * rstd * n0[2] * bflo(g0.y), ov[0][3] * rstd * n0[3] * bfhi(g0.y));
            w0.z = pk2(ov[1][0] * rstd * n1[0] * bflo(g0.z), ov[1][1] * rstd * n1[1] * bfhi(g0.z)); w0.w = pk2(ov[1][2] * rstd * n1[2] * bflo(g0.w), ov[1][3] * rstd * n1[3] * bfhi(g0.w));
            w1.x = pk2(ov[2][0] * rstd * n2[0] * bflo(g1.x), ov[2][1] * rstd * n2[1] * bfhi(g1.x)); w1.y = pk2(ov[2][2] * rstd * n2[2] * bflo(g1.y), ov[2][3] * rstd * n2[3] * bfhi(g1.y));
            w1.z = pk2(ov[3][0] * rstd * n3[0] * bflo(g1.z), ov[3][1] * rstd * n3[1] * bfhi(g1.z)); w1.w = pk2(ov[3][2] * rstd * n3[2] * bflo(g1.w), ov[3][3] * rstd * n3[3] * bfhi(g1.w));
            *(v4u*)(HQ + off) = w0; *(v4u*)(HQ + off + 8) = w1;
        }
        LBAR();
    }
}
__device__ __forceinline__ void final_norm(float* out, const bf16* h2, const float* ss2, const float* g, int G, int tid0) {
    int tid_ = tid0; asm volatile("" : "+v"(tid_)); const int tid = tid_, lane = tid & 63, wave = tid >> 6;
    const int gw = blockIdx.x * NWAVES + wave, NGW = G * NWAVES;
    f32x4 gm[4];
#pragma unroll
    for (int j = 0; j < 2; ++j) { gm[2 * j] = *(const f32x4*)(g + 512 * j + 8 * lane); gm[2 * j + 1] = *(const f32x4*)(g + 512 * j + 8 * lane + 4); }
    v4u vn[2]; float sn = 1.f;
    if (gw < M) { const v4u* xr = (const v4u*)(h2 + (size_t)gw * D) + lane; sn = ss2[gw]; vn[0] = xr[0]; vn[1] = xr[64]; }
    for (int m = gw; m < M; m += NGW) {
        const v4u v0 = vn[0], v1 = vn[1]; const float sc = sn;
        if (m + NGW < M) { const v4u* xr = (const v4u*)(h2 + (size_t)(m + NGW) * D) + lane; sn = ss2[m + NGW]; vn[0] = xr[0]; vn[1] = xr[64]; }
        const float rstd = 1.0f / sqrtf(sc * (1.f / D) + EPS);
        float* orow = out + (size_t)m * D + 8 * lane;
        *(f32x4*)(orow) = (f32x4){bflo(v0.x), bfhi(v0.x), bflo(v0.y), bfhi(v0.y)} * rstd * gm[0];
        *(f32x4*)(orow + 4) = (f32x4){bflo(v0.z), bfhi(v0.z), bflo(v0.w), bfhi(v0.w)} * rstd * gm[1];
        *(f32x4*)(orow + 512) = (f32x4){bflo(v1.x), bfhi(v1.x), bflo(v1.y), bfhi(v1.y)} * rstd * gm[2];
        *(f32x4*)(orow + 516) = (f32x4){bflo(v1.z), bfhi(v1.z), bflo(v1.w), bfhi(v1.w)} * rstd * gm[3];
    }
}

#define XB_TMO      128
#define XB_XCNT(j)  (256  + 64 * (j))
#define XB_XSUB(j)  (1280 + 64 * (j))
#define XB_XGEN(j)  (2304 + 64 * (j))
#define XB_TOP      3328
#define XB_TOPGEN   3392
#define XCD_BAR_WORDS 3456
#define XB_SPIN_CAP (1u << 18)

__device__ __forceinline__ unsigned xb_ld(unsigned* p)              { return __hip_atomic_load(p, __ATOMIC_RELAXED, __HIP_MEMORY_SCOPE_AGENT); }
__device__ __forceinline__ unsigned xb_add(unsigned* p, unsigned v) { return __hip_atomic_fetch_add(p, v, __ATOMIC_RELAXED, __HIP_MEMORY_SCOPE_AGENT); }
__device__ __forceinline__ unsigned xb_xcc_id() { return (unsigned)__builtin_amdgcn_s_getreg((3 << 11) | 20) & 0xFu; }
#define XB_SPIN(cond, bar) do { unsigned _sp = 0; while (cond) { __builtin_amdgcn_s_sleep(1); \
    if ((++_sp & 255u) == 0u) { if (xb_ld(&(bar)[XB_TMO])) break; if (_sp > XB_SPIN_CAP) { atomicAdd(&(bar)[XB_TMO], 1u); break; } } } } while (0)

struct XcdBarrier {
    unsigned* bar; unsigned x;
    volatile LAS unsigned* st;
};

__device__ __forceinline__ XcdBarrier xcd_barrier_post(unsigned* bar, volatile LAS unsigned* st, int tid0) {
    XcdBarrier b; b.bar = bar; b.x = xb_xcc_id(); b.st = st;
    if (tid0 == 0) (void)xb_add(&bar[XB_XCNT(b.x)], 1u);
    return b;
}
__device__ __forceinline__ void xcd_barrier_complete(unsigned* bar, unsigned x, unsigned& nloc, unsigned& nx) {
    const unsigned G = gridDim.x * gridDim.y * gridDim.z;
    unsigned sum, cnt, mine, sp = 0u;
    for (;;) {
        sum = 0u; cnt = 0u; mine = 0u;
#pragma unroll
        for (unsigned j = 0; j < 16; ++j) { const unsigned c = xb_ld(&bar[XB_XCNT(j)]); sum += c; cnt += (c > 0u) ? 1u : 0u; mine = (j == x) ? c : mine; }
        if (sum == G) break;
        __builtin_amdgcn_s_sleep(1);
        if ((++sp & 255u) == 0u) { if (xb_ld(&bar[XB_TMO])) break; if (sp > XB_SPIN_CAP) { atomicAdd(&bar[XB_TMO], 1u); break; } }
    }
    nloc = mine > 0u ? mine : 1u; nx = cnt > 0u ? cnt : 1u;
}

__device__ __forceinline__ void xcd_barrier(const XcdBarrier& b, int tid0) {
    asm volatile("s_waitcnt vmcnt(0)" ::: "memory");
    __syncthreads();
    if (tid0 == 0) {
        unsigned* bar = b.bar;
        __builtin_amdgcn_s_waitcnt(0);
        unsigned nloc = b.st[0], nx = b.st[1];
        if (nloc == 0u) { xcd_barrier_complete(bar, b.x, nloc, nx); b.st[0] = nloc; b.st[1] = nx; }
        const unsigned old = xb_add(&bar[XB_XSUB(b.x)], 1u);
        const unsigned gen = old / nloc;
        if (old + 1u == (gen + 1u) * nloc) {
            __builtin_amdgcn_fence(__ATOMIC_RELEASE, "agent");
            asm volatile("s_waitcnt vmcnt(0)" ::: "memory");
            const unsigned og = xb_add(&bar[XB_TOP], 1u);
            const unsigned tg = og / nx;
            if (og + 1u == (tg + 1u) * nx) xb_add(&bar[XB_TOPGEN], 1u);
            else XB_SPIN(xb_ld(&bar[XB_TOPGEN]) == tg, bar);
            __builtin_amdgcn_fence(__ATOMIC_ACQUIRE, "agent");
            xb_add(&bar[XB_XGEN(b.x)], 1u);
            asm volatile("s_waitcnt vmcnt(0)" ::: "memory");
        } else {
            XB_SPIN(xb_ld(&bar[XB_XGEN(b.x)]) == gen, bar);
            __builtin_amdgcn_fence(__ATOMIC_ACQUIRE, "agent");
            asm volatile("s_waitcnt vmcnt(0)" ::: "memory");
        }
    }
    __syncthreads();
}

__device__ __forceinline__ int lane_id_opaque() { int l; asm volatile("v_mbcnt_lo_u32_b32 %0, -1, 0\n\tv_mbcnt_hi_u32_b32 %0, -1, %0" : "=v"(l)); return l; }
struct Args { const float* in[15]; float* out; unsigned char* ws; int ph_lo, ph_hi; };
#ifndef NOPH0
#define NOPH0 0
#endif
#ifndef NOPH1
#define NOPH1 0
#endif
#ifndef NOPH2
#define NOPH2 0
#endif
#ifndef NOPH3
#define NOPH3 0
#endif
#ifndef NOPH4
#define NOPH4 0
#endif
#ifndef NOPH5
#define NOPH5 0
#endif
#ifndef NOPH6
#define NOPH6 0
#endif
#ifndef NOPH7
#define NOPH7 0
#endif
#ifndef NOPH8
#define NOPH8 0
#endif
#ifndef NOPH9
#define NOPH9 0
#endif
#ifndef NOPH10
#define NOPH10 0
#endif
#ifndef NOPH11
#define NOPH11 0
#endif
#ifndef NOPH12
#define NOPH12 0
#endif
constexpr int N_PHASES = 13;
#ifndef MK_ONE_LAUNCH
#define MK_ONE_LAUNCH 1
#endif

__global__ void __launch_bounds__(NTHR, 2) hybrid_fwd(Args args) {
    extern __shared__ __attribute__((aligned(16))) unsigned char lds_raw[];
    LAS unsigned char* lds = (LAS unsigned char*)lds_raw;
    const int G = gridDim.x;
    const int wave_s = __builtin_amdgcn_readfirstlane((int)threadIdx.x >> 6);
#define KTID() (wave_s * 64 + lane_id_opaque())
    if (args.ph_lo < 0) cg::this_grid().sync();
    Ptrs P;
    P.x = args.in[0]; P.norm_mix = args.in[1]; P.w_in = args.in[2]; P.fbias = args.in[3]; P.lblog = args.in[4]; P.hg_norm = args.in[5];
    P.w_a = args.in[6]; P.w_b = args.in[7]; P.w_o = args.in[8]; P.norm_ffn = args.in[9]; P.w_up = args.in[10]; P.conv_w = args.in[11]; P.conv_b = args.in[12];
    P.w_dn = args.in[13]; P.norm_final = args.in[14]; P.out = args.out; P.ws = args.ws;
    unsigned char* ws = args.ws;
    bf16* Wt_in = (bf16*)(ws + WS_WIN);
    bf16* S0 = (bf16*)(ws + WS_SLOT0); bf16* S1 = (bf16*)(ws + WS_SLOT0 + SLOT); bf16* S2 = (bf16*)(ws + WS_SLOT0 + 2 * SLOT); bf16* S3 = (bf16*)(ws + WS_SLOT0 + 3 * SLOT);
    bf16* S4 = (bf16*)(ws + WS_SLOT0 + 4 * SLOT); bf16* S5 = (bf16*)(ws + WS_SLOT0 + 5 * SLOT); bf16* S6 = (bf16*)(ws + WS_SLOT0 + 6 * SLOT); bf16* D0 = (bf16*)args.out;
    float* SS1 = (float*)(ws + WS_SS1); float* SS2 = (float*)(ws + WS_SS2);
    const int lo = args.ph_lo, hi = args.ph_hi;
#define IN(k) (lo <= (k) && (k) < hi)
    {   volatile LAS unsigned* barw = (volatile LAS unsigned*)(lds + BARW_OFF);
        if (KTID() < 2) barw[KTID()] = 0u;
        __syncthreads();
        if (hi - lo > 1) (void)xcd_barrier_post((unsigned*)(ws + WS_BAR), barw, KTID()); }
#define SEAM(k) do { if (IN(k) && IN((k) + 1)) { { XcdBarrier b_; b_.bar = (unsigned*)(args.ws + WS_BAR); b_.x = xb_xcc_id(); b_.st = (volatile LAS unsigned*)(lds + BARW_OFF); xcd_barrier(b_, KTID()); } } } while (0)

#ifndef PROBE_LO
#define PROBE_LO 99
#define PROBE_HI 99
#endif
    unsigned long long pr_acc = 0, pr_t0 = 0;
#define PR_BEGIN(k) do { if ((k) == PROBE_LO) pr_t0 = __builtin_amdgcn_s_memrealtime(); } while (0)
#define PR_END(k) do { if ((k) == PROBE_HI) pr_acc = __builtin_amdgcn_s_memrealtime() - pr_t0; } while (0)
    PR_BEGIN(0);
    if (IN(0) && !NOPH0) { p0_prologue(lds, P, G, KTID()); }
    SEAM(0);
    PR_END(0);
    PR_BEGIN(1);
    if (IN(1) && !NOPH1) {
        p1_cscan(lds, P, KTID());
        pg8::Gemm g{S0, Wt_in + (size_t)4096 * D, M, 3072, D, 0}; pg8::StaticOrder S; S.init(M, 3072, G, (int)blockIdx.x);
        EpiProj E{S1, S2, S3, S3, 0, 0, 0, 0, attn_body::C2, nullptr, 1.f};
        pg8::gemm_phase<EpiProj, pg8::StaticOrder, true, true>(lds, g, S, E, KTID());
    }
    SEAM(1);
    PR_END(1);
    PR_BEGIN(2);
    if (IN(2) && !NOPH2) {
        const attn_body::AttnTensors AT{(const attn_body::bf16*)S1, (const attn_body::bf16*)S2, (const attn_body::bf16*)S3, (attn_body::bf16*)S1, (const float*)(ws + WS_CL)};
        const attn_body::StaticOrder S(G, (int)blockIdx.x);
        attn_body::attn_phase<attn_body::StaticOrder>((char*)lds_raw, AT, S, KTID());
    }
    PR_END(2);
    PR_BEGIN(3);
    if (IN(3) && !NOPH3) {
        pg8::Gemm g{S0, Wt_in, M, 4096, D, 0}; pg8::StaticOrder S; S.init(M, 4096, G, (int)blockIdx.x);
        EpiProj E{S4, S5, S6, D0, 1, 2, 0, 1, 1.f, (const float*)(ws + WS_LBV), 1.f};
        pg8::gemm_phase<EpiProj, pg8::StaticOrder, true, true>(lds, g, S, E, KTID());
    }
    SEAM(3);
    PR_END(3);
    PR_BEGIN(4);
    if (IN(4) && !NOPH4) hgrn_pass_a(lds, S5, S6, S2, (float*)(ws + WS_DK), G, KTID());
    SEAM(4);
    PR_END(4);
    PR_BEGIN(5);
    if (IN(5) && !NOPH5) hgrn_pass_b((unsigned*)S2, (const float*)(ws + WS_DK), G, KTID());
    SEAM(5);
    PR_END(5);
    PR_BEGIN(6);
    if (IN(6) && !NOPH6) hgrn_pass_c(lds, S4, S5, S6, D0, S2, P.hg_norm, G, KTID());
    SEAM(6);
    PR_END(6);
    PR_BEGIN(7);
    if (IN(7) && !NOPH7) {
        pg8::Gemm g{S0, Wt_in + (size_t)7168 * D, M, 2048, D, 0}; pg8::StaticOrder S; S.init(M, 2048, G, (int)blockIdx.x);
        EpiProj E{S5, S6, S6, S6, 0, 0, 0, 0, -LOG2E, nullptr, -LOG2E};
        pg8::gemm_phase<EpiProj, pg8::StaticOrder, true, true>(lds, g, S, E, KTID());
    }
    SEAM(7);
    PR_END(7);
    PR_BEGIN(8);
    if (IN(8) && !NOPH8) {
        { pg8::Gemm g{S4, (const bf16*)(ws + WS_WA), M, D, D, 0}; pg8::StaticOrder S; S.init(M, D, G, (int)blockIdx.x);
          EpiGate E{S5, nullptr, S5};
          pg8::gemm_phase<EpiGate, pg8::StaticOrder, true, true>(lds, g, S, E, KTID()); }
        asm volatile("s_waitcnt vmcnt(0)" ::: "memory"); __builtin_amdgcn_fence(__ATOMIC_ACQUIRE, "agent"); asm volatile("s_waitcnt vmcnt(0)" ::: "memory"); __syncthreads();
        { pg8::Gemm g{S1, (const bf16*)(ws + WS_WB), M, D, D, 0}; pg8::StaticOrder S; S.init(M, D, G, (int)blockIdx.x);
          EpiGate E{S6, S5, S6};
          pg8::gemm_phase<EpiGate, pg8::StaticOrder, true, true>(lds, g, S, E, KTID()); }
    }
    SEAM(8);
    PR_END(8);
    PR_BEGIN(9);
    if (IN(9) && !NOPH9) {
        pg8::Gemm g{S6, (const bf16*)(ws + WS_WO), M, D, D, 0}; pg8::StaticOrder S; S.init(M, D, G, (int)blockIdx.x);
        EpiResB E{P.x, nullptr, S0, SS1};
        pg8::gemm_phase<EpiResB, pg8::StaticOrder, true, true>(lds, g, S, E, KTID());
    }
    SEAM(9);
    PR_END(9);
    PR_BEGIN(10);
    if (IN(10) && !NOPH10) {
        pg8::Gemm g{S0, (const bf16*)(ws + WS_WUP), M, NUP, D, 0}; pg8::StaticOrder S; S.init(M, NUP, G, (int)blockIdx.x);
        EpiConvGlu E{S1, SS1, P.conv_w, P.conv_b, lds + HALO_OFF, (float*)S4};
        pg8::gemm_phase<EpiConvGlu, pg8::StaticOrder, true, true>(lds, g, S, E, KTID());
        if (hi - lo > 1) { XcdBarrier b_; b_.bar = (unsigned*)(args.ws + WS_BAR); b_.x = xb_xcc_id(); b_.st = (volatile LAS unsigned*)(lds + BARW_OFF); xcd_barrier(b_, KTID()); }
        up_fixup((const float*)S4, P.conv_w, P.conv_b, S1, G, KTID());
    }
    SEAM(10);
    PR_END(10);
    PR_BEGIN(11);
    if (IN(11) && !NOPH11) {
        pg8::Gemm g{S1, (const bf16*)(ws + WS_WDN), M, D, DFF, 0}; pg8::StaticOrder S; S.init(M, D, G, (int)blockIdx.x);
        EpiResB E{nullptr, S0, S0, SS2};
        pg8::gemm_phase<EpiResB, pg8::StaticOrder, true, true>(lds, g, S, E, KTID());
    }
    SEAM(11);
    PR_END(11);
    PR_BEGIN(12);
    if (IN(12) && !NOPH12) final_norm(P.out, S0, SS2, P.norm_final, G, KTID());
    PR_END(12);
    if (PROBE_LO != 99) { __syncthreads(); const unsigned long long te = __builtin_amdgcn_s_memrealtime(); while (__builtin_amdgcn_s_memrealtime() - te < 4ull * pr_acc) __builtin_amdgcn_s_sleep(8); }
#undef IN
#undef SEAM
}

extern "C" void kernel_launch(void* const* d_in, const int* in_sizes, int n_in, void* d_out, int out_size, void* d_ws, size_t ws_size, hipStream_t stream) {
    static int grid = 0;
    if (grid == 0) {
        if (n_in != 15 || in_sizes[0] != M * D || out_size != M * D || ws_size < WS_END) { fprintf(stderr, "kernel_launch: unexpected shapes / workspace (%d inputs, in0 %d, out %d, ws %zu < %zu)\n", n_in, n_in > 0 ? in_sizes[0] : -1, out_size, ws_size, (size_t)WS_END); grid = -1; return; }
        int dev = 0, cus = 0, per_cu = 0;
        if (hipGetDevice(&dev) != hipSuccess || hipDeviceGetAttribute(&cus, hipDeviceAttributeMultiprocessorCount, dev) != hipSuccess) { grid = -1; return; }
        if (hipFuncSetAttribute((const void*)hybrid_fwd, hipFuncAttributeMaxDynamicSharedMemorySize, LDS_BYTES) != hipSuccess) { fprintf(stderr, "kernel_launch: hipFuncSetAttribute failed\n"); grid = -1; return; }
        if (hipOccupancyMaxActiveBlocksPerMultiprocessor(&per_cu, (const void*)hybrid_fwd, NTHR, LDS_BYTES) != hipSuccess || per_cu < 1) per_cu = 1;
        (void)hipGetLastError();
        grid = cus;
    }
    if (grid < 0) return;
    if (hipMemsetAsync((char*)d_ws + WS_BAR, 0, BAR_BYTES, stream) != hipSuccess) { fprintf(stderr, "kernel_launch: memset failed\n"); return; }
    Args a{};
    for (int i = 0; i < 15; ++i) a.in[i] = (const float*)d_in[i];
    a.out = (float*)d_out; a.ws = (unsigned char*)d_ws;
#if MK_ONE_LAUNCH
    a.ph_lo = 0; a.ph_hi = N_PHASES;
    void* kargs[] = {&a};
    hipError_t e = hipLaunchCooperativeKernel((const void*)hybrid_fwd, dim3(grid), dim3(NTHR), kargs, LDS_BYTES, stream);
    if (e != hipSuccess) fprintf(stderr, "cooperative launch failed: %s (grid %d)\n", hipGetErrorString(e), grid);
#else
    for (int p = 0; p < N_PHASES; ++p) { a.ph_lo = p; a.ph_hi = p + 1; hipLaunchKernelGGL(hybrid_fwd, dim3(grid), dim3(NTHR), LDS_BYTES, stream, a); }
#endif
}
```

```cpp
#include <hip/hip_runtime.h>
#include <hip/hip_cooperative_groups.h>
#include <hip/hip_runtime.h>
#include <cstdio>
#include <cstdint>
namespace pg8 {
#define PG8_LAS __attribute__((address_space(3)))
typedef unsigned short bf16_t;
typedef short bf16x8 __attribute__((ext_vector_type(8)));
typedef float f32x4 __attribute__((ext_vector_type(4)));
typedef unsigned u32x4 __attribute__((ext_vector_type(4)));
constexpr int BM = 256, BK = 64, HALF = 128, HTB = HALF * BK * 2  , STAGE_BYTES = 8 * HTB, NXCD = 8, WGM = 8;

__host__ __device__ __forceinline__ int lds_byte(int r, int c) { const int st = (r >> 4) * 2 + (c >> 5), rr = r & 15, cc = c & 31, ob = rr * 64 + cc * 2; return st * 1024 + (ob ^ (((ob >> 9) & 1) << 5)); }
__host__ __device__ __forceinline__ void stage_rc(int b, int& R, int& C) { const int st = b / 1024, sb = b % 1024, swz = sb ^ (((sb >> 9) & 1) << 5); R = (st >> 1) * 16 + swz / 64; C = (st & 1) * 32 + (swz % 64) / 2; }
__host__ __device__ __forceinline__ int perm32(int rho) { const int n = rho >> 4, i = rho & 15; return 8 * (i >> 2) + 4 * n + (i & 3); }

struct Unit { int pm, pn; };
struct Gemm { const bf16_t* A; const bf16_t* Bt; int M, N, K; size_t a_tstep; };

struct StaticOrder {
    int nM, nN, nwg, G, c;
    __host__ __device__ void init(int M, int N, int G_, int c_) { nM = M / BM; nN = N / BM; nwg = nM * nN; G = G_; c = c_; }
    __host__ __device__ bool next(int i, Unit& u) const {
        const long L = (long)i * G + c; if (L >= nwg) return false;
        int wgid = (int)L; { const int q = nwg / NXCD, r = nwg % NXCD, xcd = wgid % NXCD, off = wgid / NXCD; wgid = (xcd < r ? xcd * (q + 1) : r * (q + 1) + (xcd - r) * q) + off; }
        const int nig = WGM * nN, gid = wgid / nig, fm = gid * WGM, gsz = (nM - fm) < WGM ? (nM - fm) : WGM;
        u.pm = fm + ((wgid % nig) % gsz); u.pn = (wgid % nig) / gsz; return true;
    }
    __device__ __forceinline__ void a_ready(const Unit&) const {}
    __device__ __forceinline__ void done(const Unit&) const {}
};

__device__ __forceinline__ unsigned cvt_pk_bf16(float lo, float hi) { unsigned r; asm volatile("v_cvt_pk_bf16_f32 %0, %1, %2" : "=v"(r) : "v"(lo), "v"(hi)); return r; }
typedef float f32x2 __attribute__((ext_vector_type(2)));
__device__ __forceinline__ f32x2 gelu_pk(f32x2 v) {
    const f32x2 av = __builtin_elementwise_abs(v), d = av * 0.2316418882f + 1.0f;
    f32x2 t; t.x = __builtin_amdgcn_rcpf(d.x); t.y = __builtin_amdgcn_rcpf(d.y);
    f32x2 q = t * 0.5307027145f + (-0.7265760135f); q = q * t + 0.7107068705f; q = q * t + (-0.142248368f); q = q * t + 0.127414796f; q = q * t;
    const f32x2 s = (v * v) * (-0.72134752044f);
    f32x2 e; e.x = __builtin_amdgcn_exp2f(s.x); e.y = __builtin_amdgcn_exp2f(s.y);
    const f32x2 m = v * (q * e), r = v - m;
    f32x2 o; o.x = v.x < 0.f ? m.x : r.x; o.y = v.y < 0.f ? m.y : r.y; return o;
}

template <class E, class = void> struct epi_perma { static constexpr bool value = false; };
template <class E> struct epi_perma<E, decltype((void)E::PERMA)> { static constexpr bool value = E::PERMA; };
template <class Epi, class Sched, bool ALIGN_EPI = false, bool SP2 = false>
__device__ __forceinline__ void gemm_phase(PG8_LAS unsigned char* lds, const Gemm g, const Sched& S, const Epi& E, int tid0) {
    int tid_ = tid0; asm volatile("" : "+v"(tid_));
    const int tid = tid_, wid = __builtin_amdgcn_readfirstlane(tid >> 6), lane = tid & 63, wr = wid >> 2, wc = wid & 3, fr = lane & 15, fq = lane >> 4;
    const int K = g.K, nt = K / BK;
    unsigned voffA[2], voffB[2];
#pragma unroll
    for (int i = 0; i < 2; ++i) { int R, C; stage_rc(tid * 16 + i * 8192, R, C); const int Rb = Epi::PERM ? ((R & ~31) + perm32(R & 31)) : R;
        const int Ra = epi_perma<Epi>::value ? ((R & ~63) + 4 * (R & 15) + ((R >> 4) & 3)) : R;
        voffA[i] = (unsigned)(Ra * K + C) * 2u; voffB[i] = (unsigned)(Rb * K + C) * 2u; }
    const size_t kstep = (size_t)(BK * 2);
    const size_t hstep = (size_t)HALF * K * 2;
    const size_t tstep = 2 * hstep;
    const unsigned ldsw = (unsigned)wid * 1024u;
    const int aoff = lds_byte(wr * 64 + fr, fq * 8), boff = lds_byte(wc * 32 + fr, fq * 8);
#define PG8_SA(b, h) (((b) * 2 + (h)) * HTB)
#define PG8_SB(b, h) ((4 + (b) * 2 + (h)) * HTB)
#define PG8_STAGE(bufoff, gbase, voff) do { _Pragma("unroll") for (int _i = 0; _i < 2; ++_i) \
        __builtin_amdgcn_global_load_lds((const unsigned*)((const char*)(gbase) + (voff)[_i]), (PG8_LAS unsigned*)(lds + (bufoff) + ldsw + _i * 8192), 16, 0, 0); } while (0)
#define PG8_LDA(dst, b, h) do { _Pragma("unroll") for (int m = 0; m < 4; ++m) _Pragma("unroll") for (int k = 0; k < 2; ++k) dst[m][k] = *(const PG8_LAS bf16x8*)(lds + PG8_SA(b, h) + aoff + m * 2048 + k * 1024); } while (0)
#define PG8_LDB(dst, b, h) do { _Pragma("unroll") for (int n = 0; n < 2; ++n) _Pragma("unroll") for (int k = 0; k < 2; ++k) dst[n][k] = *(const PG8_LAS bf16x8*)(lds + PG8_SB(b, h) + boff + n * 2048 + k * 1024); } while (0)
#define PG8_MMA(ai, bj, At, Bt) do { __builtin_amdgcn_s_setprio(1); _Pragma("unroll") for (int m = 0; m < 4; ++m) _Pragma("unroll") for (int n = 0; n < 2; ++n) _Pragma("unroll") for (int k = 0; k < 2; ++k) \
        acc[ai][bj][m][n] = __builtin_amdgcn_mfma_f32_16x16x32_bf16(Bt[n][k], At[m][k], acc[ai][bj][m][n], 0, 0, 0); __builtin_amdgcn_s_setprio(0); } while (0)
#define PG8_WAIT_V(n) asm volatile("s_waitcnt vmcnt(" #n ")" ::: "memory")
#define PG8_WAIT_L(n) asm volatile("s_waitcnt lgkmcnt(" #n ")" ::: "memory")
#define PG8_BAR __builtin_amdgcn_s_barrier()
#define PG8_SCHED __builtin_amdgcn_sched_barrier(0)
    Unit cur, nxt; int ui = 0;
    if (!S.next(0, cur)) return;
    f32x4 acc[2][2][4][2];
#pragma unroll
    for (int a = 0; a < 2; ++a)
#pragma unroll
        for (int b = 0; b < 2; ++b)
#pragma unroll
            for (int m = 0; m < 4; ++m)
#pragma unroll
                for (int n = 0; n < 2; ++n) acc[a][b][m][n] = (f32x4){0.f, 0.f, 0.f, 0.f};
    bf16x8 At[4][2], B0[2][2], B1[2][2];
    const size_t tstepA = g.a_tstep ? g.a_tstep : tstep; const char* cA = (const char*)g.A + (size_t)cur.pm * tstepA; const char* cB = (const char*)g.Bt + (size_t)cur.pn * tstep;
    S.a_ready(cur);
    if constexpr (SP2) {
        PG8_STAGE(PG8_SB(0, 0), cB, voffB); PG8_STAGE(PG8_SB(0, 1), cB + hstep, voffB); PG8_STAGE(PG8_SA(0, 0), cA, voffA); PG8_STAGE(PG8_SA(0, 1), cA + hstep, voffA);
        if (wr == 1) PG8_BAR;
        PG8_WAIT_V(2); PG8_BAR;
        PG8_STAGE(PG8_SB(1, 0), cB + kstep, voffB); PG8_STAGE(PG8_SA(1, 0), cA + kstep, voffA); PG8_STAGE(PG8_SB(1, 1), cB + hstep + kstep, voffB);
        PG8_WAIT_V(6); PG8_BAR;
    } else {
        PG8_STAGE(PG8_SB(0, 0), cB, voffB); PG8_STAGE(PG8_SA(0, 0), cA, voffA); PG8_STAGE(PG8_SB(0, 1), cB + hstep, voffB); PG8_STAGE(PG8_SA(0, 1), cA + hstep, voffA);
        if (wr == 1) PG8_BAR;
        PG8_WAIT_V(4); PG8_BAR;
        PG8_STAGE(PG8_SB(1, 0), cB + kstep, voffB); PG8_STAGE(PG8_SA(1, 0), cA + kstep, voffA); PG8_STAGE(PG8_SB(1, 1), cB + hstep + kstep, voffB);
        PG8_WAIT_V(6); PG8_BAR;
    }
    for (;;) {
        const bool has_next = S.next(ui + 1, nxt);
        const char* nA = has_next ? (const char*)g.A + (size_t)nxt.pm * tstepA : cA; const char* nB = has_next ? (const char*)g.Bt + (size_t)nxt.pn * tstep : cB;
        for (int t = 0; t < nt; t += 2) {
            const bool last = (t == nt - 2);
            const char* a1 = cA + (size_t)(t + 1) * kstep;
            const char* a2 = last ? nA : cA + (size_t)(t + 2) * kstep; const char* b2 = last ? nB : cB + (size_t)(t + 2) * kstep;
            const char* a3 = a2 + kstep; const char* b3 = b2 + kstep;
            if (last && has_next) S.a_ready(nxt);
            if constexpr (SP2) {
            PG8_LDB(B0, 0, 0); PG8_LDB(B1, 0, 1); PG8_SCHED; PG8_LDA(At, 0, 0); PG8_STAGE(PG8_SA(1, 1), a1 + hstep, voffA);
            PG8_WAIT_V(8); PG8_WAIT_L(0); PG8_BAR; PG8_MMA(0, 0, At, B0); PG8_MMA(0, 1, At, B1); PG8_BAR; PG8_SCHED;
            PG8_LDA(At, 0, 1); PG8_STAGE(PG8_SB(0, 0), b2, voffB); PG8_STAGE(PG8_SB(0, 1), b2 + hstep, voffB); PG8_STAGE(PG8_SA(0, 0), a2, voffA);
            PG8_WAIT_V(8); PG8_WAIT_L(0); PG8_BAR; PG8_MMA(1, 0, At, B0); PG8_MMA(1, 1, At, B1); PG8_BAR; PG8_SCHED;
            PG8_LDB(B0, 1, 0); PG8_LDB(B1, 1, 1); PG8_SCHED; PG8_LDA(At, 1, 0); PG8_STAGE(PG8_SA(0, 1), a2 + hstep, voffA);
            PG8_WAIT_V(8); PG8_WAIT_L(0); PG8_BAR; PG8_MMA(0, 0, At, B0); PG8_MMA(0, 1, At, B1); PG8_BAR; PG8_SCHED;
            PG8_LDA(At, 1, 1); PG8_STAGE(PG8_SB(1, 0), b3, voffB); PG8_STAGE(PG8_SB(1, 1), b3 + hstep, voffB); PG8_STAGE(PG8_SA(1, 0), a3, voffA);
            PG8_WAIT_V(8); PG8_WAIT_L(0); PG8_BAR; PG8_MMA(1, 0, At, B0); PG8_MMA(1, 1, At, B1); PG8_BAR; PG8_SCHED;
            } else {
            PG8_LDB(B0, 0, 0); PG8_SCHED; PG8_LDA(At, 0, 0); PG8_STAGE(PG8_SA(1, 1), a1 + hstep, voffA);
            PG8_WAIT_L(8); PG8_BAR; PG8_WAIT_L(0); PG8_MMA(0, 0, At, B0); PG8_BAR; PG8_SCHED;
            PG8_LDB(B1, 0, 1); PG8_STAGE(PG8_SB(0, 0), b2, voffB);
            PG8_BAR; PG8_WAIT_L(0); PG8_MMA(0, 1, At, B1); PG8_BAR;
            PG8_LDA(At, 0, 1); PG8_STAGE(PG8_SA(0, 0), a2, voffA);
            PG8_BAR; PG8_WAIT_L(0); PG8_MMA(1, 0, At, B0); PG8_BAR; PG8_SCHED;
            PG8_STAGE(PG8_SB(0, 1), b2 + hstep, voffB);
            PG8_WAIT_V(6); PG8_BAR; PG8_MMA(1, 1, At, B1); PG8_BAR;
            PG8_LDB(B0, 1, 0); PG8_SCHED; PG8_LDA(At, 1, 0); PG8_STAGE(PG8_SA(0, 1), a2 + hstep, voffA);
            PG8_WAIT_L(8); PG8_BAR; PG8_WAIT_L(0); PG8_MMA(0, 0, At, B0); PG8_BAR; PG8_SCHED;
            PG8_LDB(B1, 1, 1); PG8_STAGE(PG8_SB(1, 0), b3, voffB);
            PG8_BAR; PG8_WAIT_L(0); PG8_MMA(0, 1, At, B1); PG8_BAR;
            PG8_LDA(At, 1, 1); PG8_STAGE(PG8_SA(1, 0), a3, voffA);
            PG8_BAR; PG8_WAIT_L(0); PG8_MMA(1, 0, At, B0); PG8_BAR; PG8_SCHED;
            PG8_STAGE(PG8_SB(1, 1), b3 + hstep, voffB);
            PG8_WAIT_V(6); PG8_BAR; PG8_MMA(1, 1, At, B1); PG8_BAR;
            }
        }
        if constexpr (ALIGN_EPI) { if (wr == 0) PG8_BAR; }
        if constexpr (!Epi::AFTER_DRAIN) { E(acc, cur, wr, wc, fr, fq); S.done(cur); }
        if (!has_next) break;
#pragma unroll
        for (int a = 0; a < 2; ++a)
#pragma unroll
            for (int b = 0; b < 2; ++b)
#pragma unroll
                for (int m = 0; m < 4; ++m)
#pragma unroll
                    for (int n = 0; n < 2; ++n) acc[a][b][m][n] = (f32x4){0.f, 0.f, 0.f, 0.f};
        cur = nxt; cA = nA; cB = nB; ++ui;
        if constexpr (ALIGN_EPI) { if (wr == 1) PG8_BAR; }
    }
    PG8_WAIT_V(0);
    if constexpr (!ALIGN_EPI) { if (wr == 0) PG8_BAR; }
    PG8_BAR;
    if constexpr (Epi::AFTER_DRAIN) { E.fused(acc, cur, wr, wc, fr, fq, lds, wid, lane); S.done(cur); }
#undef PG8_SA
#undef PG8_SB
#undef PG8_STAGE
#undef PG8_LDA
#undef PG8_LDB
#undef PG8_MMA
#undef PG8_WAIT_V
#undef PG8_WAIT_L
#undef PG8_BAR
#undef PG8_SCHED
}
}

#ifndef PG8_SP2
#define PG8_SP2 true
#endif
#ifndef PG8_ALIGN
#define PG8_ALIGN true
#endif
#include <hip/hip_bf16.h>
#include <cmath>
namespace attn_body {
using bf16=__hip_bfloat16;
using bf16x8=__attribute__((ext_vector_type(8)))short;
using s16x4=__attribute__((ext_vector_type(4)))short;
using f32x16=__attribute__((ext_vector_type(16)))float;
using u32x4=__attribute__((ext_vector_type(4)))unsigned;
constexpr int BATCH=4,NHEAD=16,SEQ=8192,D=64,DM=NHEAD*D;
constexpr int NW=8,QBLK=32,QB=QBLK*NW,KVBLK=64,NQB=SEQ/QB;
constexpr int ATTN_PITCH=DM, ATTN_UNIT_ROWS=QB;
__device__ __forceinline__ int crow(int r,int hi){return (r&3)+8*(r>>2)+4*hi;}
#define SBAR() __builtin_amdgcn_sched_barrier(0)
__device__ __forceinline__ void cmask(f32x16&p0,f32x16&p1,int jb,int qrel,int hi){
  const float NEG=-INFINITY; int kb=64*jb+4*hi;
  #pragma unroll
  for(int r=0;r<16;++r){int kv=kb+(r&3)+8*(r>>2); if(kv>qrel)p0[r]=NEG; if(kv+32>qrel)p1[r]=NEG;}
}

constexpr int NSLOT=3, SLOTB=8192;
constexpr int LDS_K=0, LDS_V=NSLOT*SLOTB, LDS_WS=2*NSLOT*SLOTB, LDS_OST=LDS_WS+NW*64*4, LDS_CB=LDS_OST+NW*4096, LDS_BYTES=LDS_CB+SEQ*8;
constexpr float C2=0.125f*1.4426950408889634f;
__device__ __forceinline__ void glds16(const void*gsrc,unsigned lds_dst){unsigned keep;
  asm volatile("s_mov_b32 %0, m0\n\ts_mov_b32 m0, %2\n\ts_nop 0\n\tglobal_load_lds_dwordx4 %1, off\n\ts_mov_b32 m0, %0":"=&s"(keep):"v"(gsrc),"s"(lds_dst):"memory");}
__device__ __forceinline__ float max3f(float a,float b,float c){float r;asm("v_max3_f32 %0, %1, %2, %3":"=v"(r):"v"(a),"v"(b),"v"(c));return r;}
__device__ __forceinline__ float max2f(float a,float b){float r;asm("v_max_f32_e32 %0, %1, %2":"=v"(r):"v"(a),"v"(b));return r;}
__device__ __forceinline__ float fadd_s(float a,float b){float r;asm("v_add_f32_e32 %0, %1, %2":"=v"(r):"v"(a),"v"(b));return r;}
__device__ __forceinline__ float fsub_s(float a,float b){float r;asm("v_sub_f32_e32 %0, %1, %2":"=v"(r):"v"(a),"v"(b));return r;}
typedef float f32x2_t __attribute__((ext_vector_type(2))); typedef float f32x4_t __attribute__((ext_vector_type(4))); typedef __bf16 bf16x2_t __attribute__((ext_vector_type(2)));
__device__ __forceinline__ unsigned cvtpk_s(float lo,float hi){f32x2_t v={lo,hi};bf16x2_t b=__builtin_convertvector(v,bf16x2_t);return __builtin_bit_cast(unsigned,b);}
#define WAIT_BAR(N) asm volatile("s_waitcnt vmcnt(" #N ") lgkmcnt(0)\n\ts_barrier":::"memory")

__device__ __forceinline__ void qkt(f32x16&p0,f32x16&p1,const char*Kslot,const bf16x8*qr,const f32x16&negm,int r32,int hi){
  const char*kb=Kslot+hi*1024+r32*16;
  #pragma unroll
  for(int d0=0;d0<4;++d0){
    const bf16x8 b0=*reinterpret_cast<const bf16x8*>(kb+d0*2048);
    const bf16x8 b1=*reinterpret_cast<const bf16x8*>(kb+d0*2048+512);
    if(d0==0){p0=__builtin_amdgcn_mfma_f32_32x32x16_bf16(b0,qr[0],negm,0,0,0);p1=__builtin_amdgcn_mfma_f32_32x32x16_bf16(b1,qr[0],negm,0,0,0);}
    else{p0=__builtin_amdgcn_mfma_f32_32x32x16_bf16(b0,qr[d0],p0,0,0,0);p1=__builtin_amdgcn_mfma_f32_32x32x16_bf16(b1,qr[d0],p1,0,0,0);}}
}
typedef __attribute__((address_space(3))) const char* lds_cptr;
typedef short v4i16_t __attribute__((ext_vector_type(4)));
__device__ __forceinline__ void kload8(bf16x8*kf,lds_cptr kp){
  kf[0]=*(const __attribute__((address_space(3))) bf16x8*)(kp);      kf[1]=*(const __attribute__((address_space(3))) bf16x8*)(kp+512);
  kf[2]=*(const __attribute__((address_space(3))) bf16x8*)(kp+2048); kf[3]=*(const __attribute__((address_space(3))) bf16x8*)(kp+2560);
  kf[4]=*(const __attribute__((address_space(3))) bf16x8*)(kp+4096); kf[5]=*(const __attribute__((address_space(3))) bf16x8*)(kp+4608);
  kf[6]=*(const __attribute__((address_space(3))) bf16x8*)(kp+6144); kf[7]=*(const __attribute__((address_space(3))) bf16x8*)(kp+6656);
}
__device__ __forceinline__ void kload2(bf16x8*kf,lds_cptr kp,int j){ kf[2*j]=*(const __attribute__((address_space(3))) bf16x8*)(kp+j*2048); kf[2*j+1]=*(const __attribute__((address_space(3))) bf16x8*)(kp+j*2048+512); }
__device__ __forceinline__ s16x4 vtr(lds_cptr p){ return __builtin_bit_cast(s16x4,__builtin_amdgcn_ds_read_tr16_b64_v4i16((__attribute__((address_space(3))) v4i16_t*)p)); }
__device__ __forceinline__ float rowmax(const f32x16&p0,const f32x16&p1){
  float a=max3f(p0[0],p0[1],p1[0]),b=max3f(p0[2],p0[3],p1[1]);a=max3f(a,p1[2],p1[3]);
  #pragma unroll
  for(int r=4;r<16;r+=4){a=max3f(a,p0[r],p0[r+1]);b=max3f(b,p0[r+2],p0[r+3]);a=max3f(a,p1[r],p1[r+1]);b=max3f(b,p1[r+2],p1[r+3]);}
  const float m=max2f(a,b);
  auto rr=__builtin_amdgcn_permlane32_swap(__float_as_uint(m),__float_as_uint(m),false,false);
  return max2f(__uint_as_float(rr[0]),__uint_as_float(rr[1]));
}
__device__ __forceinline__ void pv(f32x16*o,int vb,bf16x8 pa0,bf16x8 pa1,bf16x8 pa2,bf16x8 pa3){
  #pragma unroll
  for(int d0=0;d0<2;++d0){s16x4 lo[4],hi[4];
    #pragma unroll
    for(int ks=0;ks<4;++ks){
      asm volatile("ds_read_b64_tr_b16 %0,%1 offset:%c2":"=&v"(lo[ks]):"v"(vb),"i"(d0*4096+ks*1024):"memory");
      asm volatile("ds_read_b64_tr_b16 %0,%1 offset:%c2":"=&v"(hi[ks]):"v"(vb),"i"(d0*4096+ks*1024+512):"memory");}
    asm volatile("s_waitcnt lgkmcnt(0)":::"memory");SBAR();
    #define PK(k) (bf16x8){lo[k][0],lo[k][1],lo[k][2],lo[k][3],hi[k][0],hi[k][1],hi[k][2],hi[k][3]}
    o[d0]=__builtin_amdgcn_mfma_f32_32x32x16_bf16(pa0,PK(0),o[d0],0,0,0);
    o[d0]=__builtin_amdgcn_mfma_f32_32x32x16_bf16(pa1,PK(1),o[d0],0,0,0);
    o[d0]=__builtin_amdgcn_mfma_f32_32x32x16_bf16(pa2,PK(2),o[d0],0,0,0);
    o[d0]=__builtin_amdgcn_mfma_f32_32x32x16_bf16(pa3,PK(3),o[d0],0,0,0);
    #undef PK
  }
}

#ifndef ATTN_STORE16
#define ATTN_STORE16(p,v) (*(u32x4*)(p)=(v))
#endif
template<int THRL> __device__ __forceinline__ void attn_unit(int b,int h,int qb,const bf16*Q,const bf16*__restrict__ K,const bf16*__restrict__ V,bf16*O,const float*__restrict__ CLbh,char*shm,int tid0){
  const int tid=tid0,lane=tid&63,r32=lane&31,hi=lane>>5; const int wid=__builtin_amdgcn_readfirstlane(tid>>6);
  const long rowbase=(long)b*SEQ; const int q0=qb*QB;
  const bf16*Qw=Q+(rowbase+q0+wid*QBLK)*DM+h*D;
  const bf16*Kh=K+rowbase*DM+h*D,*Vh=V+rowbase*DM+h*D;
  const unsigned lds0=(unsigned)(uintptr_t)shm;
  float*wsf=(float*)(shm+LDS_WS)+wid*64;
  const bf16*ksrc=Kh+(long)lane*DM+wid*8;
  const bf16*vsrc=Vh+(long)(16*(wid&3)+(lane>>2))*DM+(wid>>2)*32+(lane&3)*8;
  const unsigned kdst=lds0+LDS_K+wid*1024, vdst=lds0+LDS_V+wid*1024;
  #define DMA_K(t,slot) glds16(ksrc+(long)(t)*KVBLK*DM,(unsigned)__builtin_amdgcn_readfirstlane(kdst+(slot)))
  #define DMA_V(t,slot) glds16(vsrc+(long)(t)*KVBLK*DM,(unsigned)__builtin_amdgcn_readfirstlane(vdst+(slot)))
  const char*Kbase=shm+LDS_K; bf16x8 kf[8];
  const lds_cptr shm3=(lds_cptr)shm; const lds_cptr kp0=shm3+LDS_K+hi*1024+r32*16; const lds_cptr vp0=shm3+LDS_V+((lane>>4)&1)*32+(lane&3)*8+(4*hi+((lane&15)>>2))*64;
  const int NT=(q0+QB)/KVBLK;
  { const float cref=CLbh[q0+QB-1]; unsigned long long*cbw=(unsigned long long*)(shm+LDS_CB); const int nk_=q0+QB;
    for(int jb_=0;jb_*4*NW*64<nk_;++jb_){ float cv_[4];
      _Pragma("unroll") for(int j_=0;j_<4;++j_){ const int i_=tid+(jb_*4+j_)*NW*64; cv_[j_]=(i_<nk_)?CLbh[i_]:0.f; }
      _Pragma("unroll") for(int j_=0;j_<4;++j_){ const int i_=tid+(jb_*4+j_)*NW*64; if(i_<nk_){ const float v_=cref-cv_[j_]; const unsigned b1_=cvtpk_s(v_,0.f)&0xffffu; const float r1_=v_-__uint_as_float(b1_<<16);
        const unsigned b2_=cvtpk_s(r1_,0.f)&0xffffu; const float r2_=r1_-__uint_as_float(b2_<<16); const unsigned b3_=cvtpk_s(r2_,0.f)&0xffffu;
        cbw[i_]=(unsigned long long)(b1_|(b2_<<16))|((unsigned long long)b3_<<32); } } }
    asm volatile("s_waitcnt vmcnt(0) lgkmcnt(0)\n\ts_barrier":::"memory"); }
  const lds_cptr cbp0=(lds_cptr)shm+LDS_CB+r32*8;
  const short one_=(hi==0)?(short)0x3f80:(short)0; const s16x4 ones=(s16x4){one_,one_,one_,0};
  #define BLD(t,k) ({ const s16x4 lo_=*(const __attribute__((address_space(3))) s16x4*)(cbp0+(t)*512+(k)*256); lo_; })
  DMA_K(0,0);DMA_V(0,0);DMA_K(1,SLOTB);
  bf16x8 qr[4];
  #pragma unroll
  for(int d0=0;d0<4;++d0)qr[d0]=*reinterpret_cast<const bf16x8*>(&Qw[(long)r32*DM+d0*16+hi*8]);
  float mhat=0.f,l_reg=0.f;f32x16 o[2];o[0]=f32x16{};o[1]=f32x16{};f32x16 negm=f32x16{};asm volatile("":"+v"(negm));
  const int qrel=wid*QBLK+r32;
  const float bdiag=CLbh[q0+QB-1]-CLbh[q0+qrel];
  #define CMASK(P0,P1,t) do{int jb_=(t)-(NT-4); if(jb_>=0)cmask(P0,P1,jb_,qrel,hi);}while(0)
  bool resc=false;
  #define START(P0,P1) do{ const float rm=rowmax(P0,P1); resc=false; \
    { const float dl=__builtin_fmaxf(rm,bdiag); mhat=fadd_s(mhat,dl); \
      _Pragma("unroll") for(int r=0;r<16;++r){P0[r]=fsub_s(P0[r],dl);P1[r]=fsub_s(P1[r],dl);} \
      _Pragma("unroll") for(int r=0;r<16;++r)negm[r]=-mhat; asm volatile("":"+v"(negm)); } \
    _Pragma("unroll") for(int r=0;r<16;++r)P0[r]=__builtin_amdgcn_exp2f(P0[r]); }while(0)
  #define RESC() do{ if(resc){ asm volatile("s_waitcnt lgkmcnt(0)":::"memory"); \
      _Pragma("unroll") for(int d_=0;d_<2;++d_) _Pragma("unroll") for(int r=0;r<16;++r)o[d_][r]*=wsf[crow(r,hi)]; } }while(0)
  f32x16 pA0,pA1,pB0,pB1;
  int sl_prev=0,sl_cur=0,sl_next=SLOTB;
  #define ROT() do{sl_prev=sl_cur;sl_cur=sl_next;sl_next=(sl_next==(NSLOT-1)*SLOTB)?0:sl_next+SLOTB;}while(0)
  DMA_K(2,2*SLOTB);
  WAIT_BAR(3);
  qkt(pA0,pA1,Kbase,qr,negm,r32,hi);{const s16x4 ba0_=BLD(0,0),ba1_=BLD(0,1);pA0=__builtin_amdgcn_mfma_f32_32x32x8bf16_1k(ba0_,ones,pA0,0,0,0);pA1=__builtin_amdgcn_mfma_f32_32x32x8bf16_1k(ba1_,ones,pA1,0,0,0);}asm volatile("s_nop 15\n\ts_nop 7":"+v"(pA0),"+v"(pA1));CMASK(pA0,pA1,0);
  START(pA0,pA1);
  _Pragma("unroll") for(int r=0;r<16;++r)pA1[r]=__builtin_amdgcn_exp2f(pA1[r]);
  WAIT_BAR(0);
  DMA_K(3,0);DMA_V(1,SLOTB);
  ROT();
  kload8(kf,kp0+sl_cur);
  WAIT_BAR(2);
  s16x4 vlo[8],vhi[8]; u32x4 pw0,pw1,pw2,pw3;
  #define PKW(P,B) cvtpk_s(P[B],P[B+1])
  #define PAF(k) __builtin_bit_cast(bf16x8,pw##k)
  #define VFR(i) (bf16x8){vlo[i][0],vlo[i][1],vlo[i][2],vlo[i][3],vhi[i][0],vhi[i][1],vhi[i][2],vhi[i][3]}
  #define PIN(x) asm volatile("":"+v"(x))
  #define MX3(a,b,c) __builtin_fmaxf(__builtin_fmaxf((a),(b)),(c))
  #define GAPA(MF,A0,A1,A2,A3,W0,W1,PW) do{ MF; sacc+=A0; sacc+=A1; sacc+=A2; sacc+=A3; PIN(sacc); W0; W1; PIN(PW); SBAR(); }while(0)
  #define EX(v) __builtin_amdgcn_exp2f(v)
  #define GAPB(MF,X,B) do{ MF; X[B]=EX(X[B]); X[B+1]=EX(X[B+1]); X[B+2]=EX(X[B+2]); X[B+3]=EX(X[B+3]); PIN(X); SBAR(); }while(0)
  #define VRD(i) do{ vlo[i]=vtr(vp_+(((i)>>2)*4096+((i)&3)*1024)); vhi[i]=vtr(vp_+(((i)>>2)*4096+((i)&3)*1024+512)); }while(0)
  #define KRD(G,j) do{ if(G){ kload2(kf,kp0+sl_next,j); SBAR(); } }while(0)
  #define STEP(C0,C1,P0,P1,t,GK,GV,GL) do{ SBAR(); \
    const lds_cptr vp_=vp0+sl_prev; const s16x4 ba0_=BLD(t,0),ba1_=BLD(t,1); \
    VRD(0); SBAR(); float sacc=(P0[0]+P0[1]); \
    GAPA(C0=__builtin_amdgcn_mfma_f32_32x32x16_bf16(kf[0],qr[0],negm,0,0,0), P0[2],P0[3],P0[4],P0[5],     pw0[0]=PKW(P0,0), pw0[1]=PKW(P0,2), pw0); \
    VRD(4); SBAR(); GAPA(C1=__builtin_amdgcn_mfma_f32_32x32x16_bf16(kf[1],qr[0],negm,0,0,0), P0[6],P0[7],P0[8],P0[9],     pw0[2]=PKW(P0,4), pw0[3]=PKW(P0,6), pw0); \
    VRD(1); SBAR(); GAPA(C0=__builtin_amdgcn_mfma_f32_32x32x16_bf16(kf[2],qr[1],C0,0,0,0),   P0[10],P0[11],P0[12],P0[13], pw1[0]=PKW(P0,8), pw1[1]=PKW(P0,10), pw1); \
    VRD(5); SBAR(); GAPA(C1=__builtin_amdgcn_mfma_f32_32x32x16_bf16(kf[3],qr[1],C1,0,0,0),   P0[14],P0[15],P1[0],P1[1],   pw1[2]=PKW(P0,12),pw1[3]=PKW(P0,14), pw1); \
    VRD(2); SBAR(); GAPA(C0=__builtin_amdgcn_mfma_f32_32x32x16_bf16(kf[4],qr[2],C0,0,0,0),   P1[2],P1[3],P1[4],P1[5],     pw2[0]=PKW(P1,0), pw2[1]=PKW(P1,2), pw2); \
    VRD(6); SBAR(); GAPA(C1=__builtin_amdgcn_mfma_f32_32x32x16_bf16(kf[5],qr[2],C1,0,0,0),   P1[6],P1[7],P1[8],P1[9],     pw2[2]=PKW(P1,4), pw2[3]=PKW(P1,6), pw2); \
    VRD(3); SBAR(); GAPA(C0=__builtin_amdgcn_mfma_f32_32x32x16_bf16(kf[6],qr[3],C0,0,0,0),   P1[10],P1[11],P1[12],P1[13], pw3[0]=PKW(P1,8), pw3[1]=PKW(P1,10), pw3); \
    VRD(7); SBAR(); GAPA(C1=__builtin_amdgcn_mfma_f32_32x32x16_bf16(kf[7],qr[3],C1,0,0,0),   P1[14],P1[15],0.f,0.f,       pw3[2]=PKW(P1,12),pw3[3]=PKW(P1,14), pw3); \
    C0=__builtin_amdgcn_mfma_f32_32x32x8bf16_1k(ba0_,ones,C0,0,0,0); C1=__builtin_amdgcn_mfma_f32_32x32x8bf16_1k(ba1_,ones,C1,0,0,0); SBAR(); \
    l_reg+=sacc; \
    if(GK){DMA_K((t)+3,sl_cur);} if(GV){DMA_V((t)+1,sl_next);} \
    CMASK(C0,C1,t); \
    { float a=MX3(C0[0],C0[1],C1[0]),b=MX3(C0[2],C0[3],C1[1]); a=MX3(a,C1[2],C1[3]); \
      _Pragma("unroll") for(int r=4;r<16;r+=4){a=MX3(a,C0[r],C0[r+1]);b=MX3(b,C0[r+2],C0[r+3]);a=MX3(a,C1[r],C1[r+1]);b=MX3(b,C1[r+2],C1[r+3]);} \
      float rm=__builtin_fmaxf(a,b); { auto rr=__builtin_amdgcn_permlane32_swap(__float_as_uint(rm),__float_as_uint(rm),false,false); rm=__builtin_fmaxf(__uint_as_float(rr[0]),__uint_as_float(rr[1])); } \
      resc=false; \
      if(__builtin_expect(__any(rm>(float)THRL),0)){ const float dl=__builtin_fmaxf(rm,0.f); mhat+=dl; \
        _Pragma("unroll") for(int r=0;r<16;++r){C0[r]-=dl;C1[r]-=dl;} \
        _Pragma("unroll") for(int r=0;r<16;++r)negm[r]=-mhat; asm volatile("":"+v"(negm)); \
        const float f=__builtin_amdgcn_exp2f(-dl); l_reg*=f; if(hi==0)wsf[r32]=f; resc=true; } } \
    SBAR(); \
    GAPB(o[0]=__builtin_amdgcn_mfma_f32_32x32x16_bf16(PAF(0),VFR(0),o[0],0,0,0), C0,0); \
    GAPB(o[1]=__builtin_amdgcn_mfma_f32_32x32x16_bf16(PAF(0),VFR(4),o[1],0,0,0), C0,4); \
    KRD(GL,0); GAPB(o[0]=__builtin_amdgcn_mfma_f32_32x32x16_bf16(PAF(1),VFR(1),o[0],0,0,0), C0,8); \
    KRD(GL,1); GAPB(o[1]=__builtin_amdgcn_mfma_f32_32x32x16_bf16(PAF(1),VFR(5),o[1],0,0,0), C0,12); \
    KRD(GL,2); GAPB(o[0]=__builtin_amdgcn_mfma_f32_32x32x16_bf16(PAF(2),VFR(2),o[0],0,0,0), C1,0); \
    KRD(GL,3); GAPB(o[1]=__builtin_amdgcn_mfma_f32_32x32x16_bf16(PAF(2),VFR(6),o[1],0,0,0), C1,4); \
    GAPB(o[0]=__builtin_amdgcn_mfma_f32_32x32x16_bf16(PAF(3),VFR(3),o[0],0,0,0), C1,8); \
    GAPB(o[1]=__builtin_amdgcn_mfma_f32_32x32x16_bf16(PAF(3),VFR(7),o[1],0,0,0), C1,12); \
    }while(0)
  int t=1;
  #undef CMASK
  #define CMASK(P0,P1,t) do{}while(0)
  for(;t+5<NT;t+=2){
    STEP(pB0,pB1,pA0,pA1,t,true,true,true);     WAIT_BAR(2); RESC(); ROT();
    STEP(pA0,pA1,pB0,pB1,t+1,true,true,true);   WAIT_BAR(2); RESC(); ROT();
  }
  #undef CMASK
  #define CMASK(P0,P1,t) do{int jb_=(t)-(NT-4); if(jb_>=0)cmask(P0,P1,jb_,qrel,hi);}while(0)
  #define ENDW(tt) do{ if((tt)+3<NT){WAIT_BAR(2);} else if((tt)+2<NT){WAIT_BAR(1);} else {WAIT_BAR(0);} }while(0)
  for(;t+1<NT;t+=2){
    STEP(pB0,pB1,pA0,pA1,t,(t+3<NT),(t+1<NT),(t+1<NT));       ENDW(t);   RESC(); ROT();
    STEP(pA0,pA1,pB0,pB1,t+1,(t+4<NT),(t+2<NT),(t+2<NT));     ENDW(t+1); RESC(); ROT();
  }
  STEP(pB0,pB1,pA0,pA1,NT-1,false,false,false); RESC();
  { float sacc=pB0[0]+pB0[1]; _Pragma("unroll") for(int r=2;r<16;++r)sacc+=pB0[r]; _Pragma("unroll") for(int r=0;r<16;++r)sacc+=pB1[r]; l_reg+=sacc;
    pw0=(u32x4){PKW(pB0,0),PKW(pB0,2),PKW(pB0,4),PKW(pB0,6)};pw1=(u32x4){PKW(pB0,8),PKW(pB0,10),PKW(pB0,12),PKW(pB0,14)};pw2=(u32x4){PKW(pB1,0),PKW(pB1,2),PKW(pB1,4),PKW(pB1,6)};pw3=(u32x4){PKW(pB1,8),PKW(pB1,10),PKW(pB1,12),PKW(pB1,14)};
    SBAR(); pv(o,(int)(lds0+LDS_V)+((lane>>4)&1)*32+(lane&3)*8+(4*hi+((lane&15)>>2))*64+sl_cur,PAF(0),PAF(1),PAF(2),PAF(3)); }
  #undef PKW
  #undef PAF
  #undef VFR
  #undef PIN
  #undef MX3
  #undef GAPA
  #undef GAPB
  #undef EX
  #undef VRD
  #undef KRD
  #undef STEP
  #undef ENDW
  {auto rr=__builtin_amdgcn_permlane32_swap(__float_as_uint(l_reg),__float_as_uint(l_reg),false,false);l_reg=__uint_as_float(rr[0])+__uint_as_float(rr[1]);}
  if(hi==0)wsf[32+r32]=l_reg;asm volatile("s_waitcnt lgkmcnt(0)":::"memory");
  float rli[16];
  #pragma unroll
  for(int r=0;r<16;++r)rli[r]=__builtin_amdgcn_rcpf(wsf[32+crow(r,hi)]);
  bf16*Ow=O+(rowbase+q0+wid*QBLK)*DM+h*D;
  { bf16*stg=(bf16*)(shm+LDS_OST)+wid*2048;
    #pragma unroll
    for(int r=0;r<16;++r){const int orow=crow(r,hi);
      #pragma unroll
      for(int d0=0;d0<2;++d0)stg[orow*64+d0*32+r32]=__float2bfloat16(o[d0][r]*rli[r]);}
    asm volatile("s_waitcnt lgkmcnt(0)":::"memory");
    #pragma unroll
    for(int i=0;i<4;++i){const int row=i*8+(lane>>3),ch=lane&7; const u32x4 v=*(const u32x4*)(stg+row*64+ch*8); ATTN_STORE16(Ow+(long)row*DM+ch*8,v);} }
  asm volatile("s_waitcnt lgkmcnt(0)\n\ts_barrier":::"memory");
  #undef DMA_K
  #undef BLD
  #undef DMA_V
  #undef CMASK
  #undef START
  #undef RESC
  #undef ROT
}
constexpr int ATTN_LDS_BYTES=LDS_BYTES;
struct AttnTensors { const bf16* Q; const bf16* K; const bf16* V; bf16* O; const float* CL; };
struct AttnUnit { int bh; int qb; };
struct StaticOrder {
  int vcu;
  __device__ __forceinline__ explicit StaticOrder(int grid,int block):vcu((block%8)*(grid/8)+block/8){}
  __device__ __forceinline__ bool next(int i,AttnUnit&u)const{ if(i>=8)return false; const int s=vcu&7,j=i&3; u.bh=(vcu>>3)+32*(i>>2); u.qb=(j==0)?s:(j==1)?15-s:(j==2)?16+s:31-s; return true; }
  __device__ __forceinline__ void a_ready(const AttnUnit&)const{}
  __device__ __forceinline__ void done(const AttnUnit&)const{}
};
template<class Sched,int THRL=8> __device__ __forceinline__ void attn_phase(char*lds,const AttnTensors&T,const Sched&S,int tid0){
  AttnUnit u;
  for(int i=0;S.next(i,u);++i){ S.a_ready(u); attn_unit<THRL>(u.bh/NHEAD,u.bh%NHEAD,u.qb,T.Q,T.K,T.V,T.O,T.CL+(long)u.bh*SEQ,lds,tid0); S.done(u); }
}
#undef SBAR
#undef WAIT_BAR
}
namespace cg = cooperative_groups;
#define LAS __attribute__((address_space(3)))
typedef unsigned short bf16;
typedef unsigned v4u __attribute__((ext_vector_type(4)));
typedef unsigned v2u __attribute__((ext_vector_type(2)));
typedef float f32x4 __attribute__((ext_vector_type(4)));
typedef float f32x16 __attribute__((ext_vector_type(16)));
typedef short bf16x8 __attribute__((ext_vector_type(8)));
typedef short s16x4 __attribute__((ext_vector_type(4)));
typedef float f32x2v __attribute__((ext_vector_type(2)));

constexpr int NWAVES = 8, NTHR = 512;
constexpr int BATCH = 4, SEQ = 8192, D = 1024, M = BATCH * SEQ;
constexpr int DIN = 9232, DFF = 2816, NUP = 2 * DFF;
constexpr float EPS = 1e-6f, LOG2E = 1.4426950408889634f;
constexpr size_t MiB = 1u << 20;
constexpr size_t WS_SS1 = 0, WS_SS2 = 128 * 1024, WS_LBV = 256 * 1024, WS_BAR = 512 * 1024, BAR_BYTES = 16384;
constexpr size_t WS_FLOG = 1 * MiB, WS_CL = 3 * MiB, WS_DK = 5 * MiB;
constexpr size_t WS_WIN = 8 * MiB, WS_WA = 26 * MiB, WS_WB = 28 * MiB, WS_WO = 30 * MiB, WS_WUP = 32 * MiB, WS_WDN = 43 * MiB;
constexpr size_t WS_SLOT0 = 52 * MiB, SLOT = 64 * MiB;
constexpr size_t WS_END = WS_SLOT0 + 7 * SLOT;
constexpr int RING_BYTES = 131072, HALO_OFF = RING_BYTES, MISC_OFF = RING_BYTES + 8192, LDS_BYTES = 151552, BARW_OFF = LDS_BYTES - 64;
constexpr int UP_TM = 254, UP_NM = 130;
static_assert(attn_body::ATTN_LDS_BYTES <= LDS_BYTES, "attention LDS");

#define LDS_WAIT() asm volatile("s_waitcnt lgkmcnt(0)" ::: "memory")
__device__ __forceinline__ unsigned f2bf(float f) { unsigned u = __builtin_bit_cast(unsigned, f); return (u + 0x7fffu + ((u >> 16) & 1u)) >> 16; }
typedef float f32x2_g __attribute__((ext_vector_type(2))); typedef __bf16 bf16x2_g __attribute__((ext_vector_type(2)));
__device__ __forceinline__ unsigned pk2c(float lo, float hi) { const f32x2_g v = {lo, hi}; const bf16x2_g b = __builtin_convertvector(v, bf16x2_g); return __builtin_bit_cast(unsigned, b); }
__device__ __forceinline__ unsigned pk2(float lo, float hi) { return pg8::cvt_pk_bf16(lo, hi); }
__device__ __forceinline__ float bf2f(unsigned short v) { return __builtin_bit_cast(float, (unsigned)v << 16); }
__device__ __forceinline__ float bflo(unsigned w) { return __builtin_bit_cast(float, w << 16); }
__device__ __forceinline__ float bfhi(unsigned w) { return __builtin_bit_cast(float, w & 0xffff0000u); }
__device__ __forceinline__ float wave_sum(float v) {
#pragma unroll
    for (int o = 1; o < 64; o <<= 1) v += __shfl_xor(v, o);
    return v;
}
__device__ __forceinline__ float fexp(float x) { return __builtin_amdgcn_exp2f(x * LOG2E); }
__device__ __forceinline__ float flog(float x) { return __builtin_amdgcn_logf(x) * 0.6931471805599453f; }
__device__ __forceinline__ float fsigmoid(float x) { return __builtin_amdgcn_rcpf(1.0f + fexp(-x)); }
__device__ __forceinline__ int crow(int r, int hi) { return (r & 3) + 8 * (r >> 2) + 4 * hi; }

__device__ __forceinline__ void transpose_item(const float* W, int ldw, bf16* WT, int Kd, int k0, int n0, int dst_row0, LAS float* scr, int lane, const float* kscale = nullptr) {
    float tv[32];
#pragma unroll
    for (int i = 0; i < 32; ++i) tv[i] = W[(size_t)(k0 + 2 * i + (lane >> 5)) * ldw + n0 + (lane & 31)];
    if (kscale) {
#pragma unroll
        for (int i = 0; i < 32; ++i) tv[i] *= kscale[k0 + 2 * i + (lane >> 5)]; }
#pragma unroll
    for (int i = 0; i < 32; ++i) scr[(2 * i + (lane >> 5)) * 33 + (lane & 31)] = tv[i];
    LDS_WAIT(); asm volatile("" ::: "memory");
    const int c = lane & 7;
#pragma unroll
    for (int j = 0; j < 4; ++j) { const int n = (lane >> 3) + 8 * j; const LAS float* s = scr + (8 * c) * 33 + n;
        v4u o; o.x = pk2(s[0 * 33], s[1 * 33]); o.y = pk2(s[2 * 33], s[3 * 33]); o.z = pk2(s[4 * 33], s[5 * 33]); o.w = pk2(s[6 * 33], s[7 * 33]);
        *(v4u*)(WT + (size_t)(dst_row0 + n) * Kd + k0 + 8 * c) = o; }
    LDS_WAIT(); asm volatile("" ::: "memory");
}

struct Ptrs {
    const float *x, *norm_mix, *w_in, *fbias, *lblog, *hg_norm, *w_a, *w_b, *w_o, *norm_ffn, *w_up, *conv_w, *conv_b, *w_dn, *norm_final;
    float* out; unsigned char* ws;
};

__device__ __forceinline__ void p0_row(const f32x4 (&vin)[4], int m, const f32x4 (&gm)[4], float fb, const LAS float* wf, bf16* XN, float* FLOG, int lane) {
        f32x4 v[4]; float s2 = 0.f;
#pragma unroll
        for (int j = 0; j < 4; ++j) { v[j] = vin[j]; s2 += (v[j].x * v[j].x + v[j].y * v[j].y) + (v[j].z * v[j].z + v[j].w * v[j].w); }
        const float rstd = 1.0f / sqrtf(wave_sum(s2) * (1.f / D) + EPS);
        unsigned long long* o8 = (unsigned long long*)(XN + (size_t)m * D) + lane;
        float acc[16];
#pragma unroll
        for (int i = 0; i < 16; ++i) acc[i] = 0.f;
#pragma unroll
        for (int j = 0; j < 4; ++j) {
            v[j] = v[j] * rstd * gm[j];
            o8[64 * j] = (unsigned long long)pk2(v[j].x, v[j].y) | ((unsigned long long)pk2(v[j].z, v[j].w) << 32);
#pragma unroll
            for (int e = 0; e < 4; ++e) { const LAS f32x4* wr = (const LAS f32x4*)wf + ((j * 4 + e) * 64 + lane); const float xv = v[j][e];
#pragma unroll
                for (int q = 0; q < 4; ++q) { const f32x4 w = wr[q * 1024]; acc[4 * q] += xv * w.x; acc[4 * q + 1] += xv * w.y; acc[4 * q + 2] += xv * w.z; acc[4 * q + 3] += xv * w.w; } }
        }
        float a8[8], a4[4], a2[2], a1;
        { const bool up = lane & 32;
#pragma unroll
          for (int i = 0; i < 8; ++i) { const float mine = up ? acc[i + 8] : acc[i], oth = up ? acc[i] : acc[i + 8]; a8[i] = mine + __shfl_xor(oth, 32); } }
        { const bool up = lane & 16;
#pragma unroll
          for (int i = 0; i < 4; ++i) { const float mine = up ? a8[i + 4] : a8[i], oth = up ? a8[i] : a8[i + 4]; a4[i] = mine + __shfl_xor(oth, 16); } }
        { const bool up = lane & 8;
#pragma unroll
          for (int i = 0; i < 2; ++i) { const float mine = up ? a4[i + 2] : a4[i], oth = up ? a4[i] : a4[i + 2]; a2[i] = mine + __shfl_xor(oth, 8); } }
        { const bool up = lane & 4; const float mine = up ? a2[1] : a2[0], oth = up ? a2[0] : a2[1]; a1 = mine + __shfl_xor(oth, 4); }
        a1 += __shfl_xor(a1, 2); a1 += __shfl_xor(a1, 1);
        const float z = a1 + fb;
        const float ls = fminf(z, 0.f) - log1pf(expf(-fabsf(z)));
        if ((lane & 3) == 0) FLOG[(size_t)m * 16 + (lane >> 2)] = ls;
}
__device__ __forceinline__ void p0_prologue(LAS unsigned char* lds, const Ptrs& P, int G, int tid0) {
    int tid_ = tid0; asm volatile("" : "+v"(tid_)); const int tid = tid_, lane = tid & 63, wave = tid >> 6;
    const int gw = blockIdx.x * NWAVES + wave, NGW = G * NWAVES;
    unsigned char* ws = P.ws;
    bf16* Wt_in = (bf16*)(ws + WS_WIN);
    {
        LAS float* scr = (LAS float*)(lds + wave * 16384);
        constexpr int I0 = 16 * 224, I1 = 16 * 64, I2 = 16 * 32, I5 = 16 * 176, I6 = 44 * 32;
        constexpr int NIT = I0 + I1 + 3 * I2 + I5 + I6;
        for (int it = gw; it < NIT; it += NGW) {
            int r = it;
            if (r < I0) { const int kb = r / 224, nb = r % 224; transpose_item(P.w_in, DIN, Wt_in, D, 64 * kb, 32 * nb, 32 * nb, scr, lane); continue; } r -= I0;
            if (r < I1) { const int kb = r / 64, nb = r % 64; transpose_item(P.w_in + 7184, DIN, Wt_in, D, 64 * kb, 32 * nb, 7168 + 32 * nb, scr, lane); continue; } r -= I1;
            if (r < I2) { const int kb = r / 32, nb = r % 32; transpose_item(P.w_a, D, (bf16*)(ws + WS_WA), D, 64 * kb, 32 * nb, 32 * nb, scr, lane); continue; } r -= I2;
            if (r < I2) { const int kb = r / 32, nb = r % 32; transpose_item(P.w_b, D, (bf16*)(ws + WS_WB), D, 64 * kb, 32 * nb, 32 * nb, scr, lane); continue; } r -= I2;
            if (r < I2) { const int kb = r / 32, nb = r % 32; transpose_item(P.w_o, D, (bf16*)(ws + WS_WO), D, 64 * kb, 32 * nb, 32 * nb, scr, lane); continue; } r -= I2;
            if (r < I5) { const int kb = r / 176, nb = r % 176; const int n0 = 32 * nb; const int nn = n0 < DFF ? n0 : n0 - DFF;
                const int dst = 256 * (nn / 128) + (nn % 128) + (n0 < DFF ? 0 : 128);
                transpose_item(P.w_up, NUP, (bf16*)(ws + WS_WUP), D, 64 * kb, n0, dst, scr, lane, P.norm_ffn); continue; } r -= I5;
            { const int kb = r / 32, nb = r % 32; transpose_item(P.w_dn, D, (bf16*)(ws + WS_WDN), DFF, 64 * kb, 32 * nb, 32 * nb, scr, lane); }
        }
    }
    { float* ss = (float*)(ws + WS_SS1); for (int i = blockIdx.x * NTHR + tid; i < 2 * M; i += G * NTHR) ss[i] = 0.f; }
    if (blockIdx.x == 0) { float* lbv = (float*)(ws + WS_LBV); for (int k = tid; k < 1024; k += NTHR) lbv[k] = fsigmoid(P.lblog[k] - P.lblog[1024 + k]); }
    __syncthreads();
    LAS float* wf = (LAS float*)lds;
    for (int i = tid; i < 1024 * 16; i += NTHR) { const int k = i >> 4, h = i & 15; const int kp = ((k >> 8) * 4 + (k & 3)) * 64 + ((k >> 2) & 63);
        wf[(((h >> 2) * 1024 + kp) << 2) + (h & 3)] = P.w_in[(size_t)k * DIN + 7168 + h]; }
    __syncthreads();
    f32x4 gm[4];
#pragma unroll
    for (int j = 0; j < 4; ++j) gm[j] = ((const f32x4*)P.norm_mix)[lane + 64 * j];
    const float fb = P.fbias[(lane >> 2) & 15];
    bf16* XN = (bf16*)(ws + WS_SLOT0);
    float* FLOG = (float*)(ws + WS_FLOG);
    f32x4 r0[4], r1[4], r2[4], r3[4];
#define P0_LOAD(r, mm) do { if ((mm) < M) { const f32x4* xr_ = (const f32x4*)(P.x + (size_t)(mm) * D) + lane; _Pragma("unroll") for (int j = 0; j < 4; ++j) r[j] = xr_[64 * j]; } } while (0)
#define P0_ROW(r, mm) do { if ((mm) < M) p0_row(r, (mm), gm, fb, wf, XN, FLOG, lane); } while (0)
    P0_LOAD(r0, gw); P0_LOAD(r1, gw + NGW); P0_LOAD(r2, gw + 2 * NGW);
    for (int m = gw; m < M; m += 4 * NGW) {
        P0_LOAD(r3, m + 3 * NGW); P0_ROW(r0, m);
        P0_LOAD(r0, m + 4 * NGW); P0_ROW(r1, m + NGW);
        P0_LOAD(r1, m + 5 * NGW); P0_ROW(r2, m + 2 * NGW);
        P0_LOAD(r2, m + 6 * NGW); P0_ROW(r3, m + 3 * NGW);
    }
#undef P0_LOAD
#undef P0_ROW
}

__device__ __forceinline__ void p1_cscan(LAS unsigned char* lds, const Ptrs& P, int tid0) {
    if (blockIdx.x >= 64) return;
    int tid_ = tid0; asm volatile("" : "+v"(tid_)); const int tid = tid_, lane = tid & 63, wave = tid >> 6;
    const int s = blockIdx.x, b = s >> 4, h = s & 15;
    const float* fl = (const float*)(P.ws + WS_FLOG) + (size_t)b * SEQ * 16 + h;
    float v[16]; float run = 0.f;
#pragma unroll
    for (int j = 0; j < 16; ++j) { run += fl[(size_t)(16 * tid + j) * 16]; v[j] = run; }
    float tot = run;
#pragma unroll
    for (int o = 1; o < 64; o <<= 1) { const float t = __shfl_up(tot, o); if (lane >= o) tot += t; }
    LAS float* wsum = (LAS float*)(lds + MISC_OFF);
    if (lane == 63) wsum[wave] = tot;
    __syncthreads();
    float base = 0.f;
#pragma unroll
    for (int w = 0; w < 8; ++w) if (w < wave) base += wsum[w];
    const float pre = base + tot - run;
    float* cl = (float*)(P.ws + WS_CL) + (size_t)s * SEQ + 16 * tid;
#pragma unroll
    for (int j = 0; j < 16; ++j) cl[j] = (pre + v[j]) * LOG2E;
    __syncthreads();
}

using pg8::Unit; using pg8::HALF; using pg8::BM;
struct EpiProj {
    static constexpr bool PERM = true, AFTER_DRAIN = false;
    bf16 *o0, *o1, *o2, *o3; int m0, m1, m2, m3; float scale0; const float* lbv;
    __device__ __forceinline__ void operator()(const f32x4 (&acc)[2][2][4][2], const Unit& u, int wr, int wc, int fr, int fq) const {
        const int colt = u.pn * BM, seg = colt >> 10, colin = colt & 1023;
        bf16* base = (bf16*)((uintptr_t)(seg == 0) * (uintptr_t)o0 + (uintptr_t)(seg == 1) * (uintptr_t)o1 + (uintptr_t)(seg == 2) * (uintptr_t)o2 + (uintptr_t)(seg == 3) * (uintptr_t)o3);
        const int mode = (seg == 0) * m0 + (seg == 1) * m1 + (seg == 2) * m2 + (seg == 3) * m3;
        const float sc = seg == 0 ? scale0 : 1.f;
        const int row0 = u.pm * BM + wr * 64 + fr, col0 = colin + wc * 32 + 8 * fq;
#pragma unroll
        for (int ai = 0; ai < 2; ++ai)
#pragma unroll
            for (int m = 0; m < 4; ++m) { bf16* rowp = base + (size_t)(row0 + ai * HALF + m * 16) * D + col0;
#pragma unroll
                for (int bj = 0; bj < 2; ++bj) { const f32x4 a0 = acc[ai][bj][m][0], a1 = acc[ai][bj][m][1];
                    float r[8] = {a0[0], a0[1], a0[2], a0[3], a1[0], a1[1], a1[2], a1[3]};
                    if (mode == 0) {
#pragma unroll
                        for (int q = 0; q < 8; ++q) r[q] *= sc;
                    } else if (mode == 1) {
#pragma unroll
                        for (int q = 0; q < 8; ++q) r[q] = r[q] * fsigmoid(r[q]);
                    } else {
                        const f32x4 l0 = *(const f32x4*)(lbv + col0 + bj * HALF), l1 = *(const f32x4*)(lbv + col0 + bj * HALF + 4);
                        const float l8[8] = {l0[0], l0[1], l0[2], l0[3], l1[0], l1[1], l1[2], l1[3]};
#pragma unroll
                        for (int q = 0; q < 8; ++q) r[q] = flog(l8[q] + (1.f - l8[q]) * fsigmoid(r[q]));
                    }
                    v4u w; w.x = pk2(r[0], r[1]); w.y = pk2(r[2], r[3]); w.z = pk2(r[4], r[5]); w.w = pk2(r[6], r[7]);
                    *(v4u*)(rowp + bj * HALF) = w; }
                if (m & 1) asm volatile("" ::: "memory"); }
    }
};
struct EpiGate {
    static constexpr bool PERM = true, AFTER_DRAIN = false;
    const bf16* gate; const bf16* add; bf16* out;
    __device__ __forceinline__ void operator()(const f32x4 (&acc)[2][2][4][2], const Unit& u, int wr, int wc, int fr, int fq) const {
        const int row0 = u.pm * BM + wr * 64 + fr, col0 = u.pn * BM + wc * 32 + 8 * fq;
#pragma unroll
        for (int ai = 0; ai < 2; ++ai)
#pragma unroll
            for (int m = 0; m < 4; ++m) { const size_t off = (size_t)(row0 + ai * HALF + m * 16) * D + col0;
#pragma unroll
                for (int bj = 0; bj < 2; ++bj) {
                    const v4u g = *(const v4u*)(gate + off + bj * HALF);
                    v4u a = (v4u){0u, 0u, 0u, 0u}; if (add) a = *(const v4u*)(add + off + bj * HALF);
                    const f32x4 v0 = acc[ai][bj][m][0], v1 = acc[ai][bj][m][1];
                    float r[8];
                    r[0] = bflo(a.x) + fsigmoid(bflo(g.x)) * v0[0]; r[1] = bfhi(a.x) + fsigmoid(bfhi(g.x)) * v0[1];
                    r[2] = bflo(a.y) + fsigmoid(bflo(g.y)) * v0[2]; r[3] = bfhi(a.y) + fsigmoid(bfhi(g.y)) * v0[3];
                    r[4] = bflo(a.z) + fsigmoid(bflo(g.z)) * v1[0]; r[5] = bfhi(a.z) + fsigmoid(bfhi(g.z)) * v1[1];
                    r[6] = bflo(a.w) + fsigmoid(bflo(g.w)) * v1[2]; r[7] = bfhi(a.w) + fsigmoid(bfhi(g.w)) * v1[3];
                    v4u w; w.x = pk2(r[0], r[1]); w.y = pk2(r[2], r[3]); w.z = pk2(r[4], r[5]); w.w = pk2(r[6], r[7]);
                    *(v4u*)(out + off + bj * HALF) = w; }
                if (m & 1) asm volatile("" ::: "memory"); }
    }
};
struct EpiRes {
    static constexpr bool PERM = false, AFTER_DRAIN = false;
    const float* base; float* out; bf16* xh; const float* gcol; float* ss;
    __device__ __forceinline__ void operator()(const f32x4 (&acc)[2][2][4][2], const Unit& u, int wr, int wc, int fr, int fq) const {
        const int col0 = u.pn * BM + wc * 32 + 4 * fq;
        f32x4 gv[2][2];
#pragma unroll
        for (int bj = 0; bj < 2; ++bj)
#pragma unroll
            for (int n = 0; n < 2; ++n) gv[bj][n] = xh ? *(const f32x4*)(gcol + col0 + bj * HALF + n * 16) : (f32x4){0.f, 0.f, 0.f, 0.f};
#pragma unroll
        for (int ai = 0; ai < 2; ++ai)
#pragma unroll
            for (int m = 0; m < 4; ++m) { const int row = u.pm * BM + ai * HALF + wr * 64 + m * 16 + fr; const size_t off = (size_t)row * D + col0; float s = 0.f;
#pragma unroll
                for (int bj = 0; bj < 2; ++bj)
#pragma unroll
                    for (int n = 0; n < 2; ++n) { const f32x4 h = *(const f32x4*)(base + off + bj * HALF + n * 16) + acc[ai][bj][m][n];
                        *(f32x4*)(out + off + bj * HALF + n * 16) = h; s += (h[0] * h[0] + h[1] * h[1]) + (h[2] * h[2] + h[3] * h[3]);
                        if (xh) { const f32x4 g = h * gv[bj][n]; v2u w; w.x = pk2(g[0], g[1]); w.y = pk2(g[2], g[3]); *(v2u*)(xh + off + bj * HALF + n * 16) = w; } }
                s += __shfl_xor(s, 16); s += __shfl_xor(s, 32);
                if (fq == 0) atomicAdd(ss + row, s);
                asm volatile("" ::: "memory"); }
    }
};
struct EpiResB {
    static constexpr bool PERM = true, AFTER_DRAIN = false;
    const float* basef; const bf16* baseb; bf16* outb; float* ss;
    __device__ __forceinline__ void operator()(const f32x4 (&acc)[2][2][4][2], const Unit& u, int wr, int wc, int fr, int fq) const {
        const int col0 = u.pn * BM + wc * 32 + 8 * fq;
#pragma unroll
        for (int ai = 0; ai < 2; ++ai)
#pragma unroll
            for (int m = 0; m < 4; ++m) { const int row = u.pm * BM + ai * HALF + wr * 64 + m * 16 + fr; const size_t off = (size_t)row * D + col0; float s = 0.f;
#pragma unroll
                for (int bj = 0; bj < 2; ++bj) {
                    f32x4 b0, b1;
                    if (basef) { b0 = *(const f32x4*)(basef + off + bj * HALF); b1 = *(const f32x4*)(basef + off + bj * HALF + 4); }
                    else { const v4u w = *(const v4u*)(baseb + off + bj * HALF); b0 = (f32x4){bflo(w.x), bfhi(w.x), bflo(w.y), bfhi(w.y)}; b1 = (f32x4){bflo(w.z), bfhi(w.z), bflo(w.w), bfhi(w.w)}; }
                    const f32x4 h0 = b0 + acc[ai][bj][m][0], h1 = b1 + acc[ai][bj][m][1];
                    s += ((h0[0] * h0[0] + h0[1] * h0[1]) + (h0[2] * h0[2] + h0[3] * h0[3])) + ((h1[0] * h1[0] + h1[1] * h1[1]) + (h1[2] * h1[2] + h1[3] * h1[3]));
                    v4u o; o.x = pk2(h0[0], h0[1]); o.y = pk2(h0[2], h0[3]); o.z = pk2(h1[0], h1[1]); o.w = pk2(h1[2], h1[3]);
                    *(v4u*)(outb + off + bj * HALF) = o; }
                s += __shfl_xor(s, 16); s += __shfl_xor(s, 32);
                if (fq == 0) atomicAdd(ss + row, s);
                if (m & 1) asm volatile("" ::: "memory"); }
    }
};
#define DPP_ROR1 0x121
#define DPP_ROR2 0x122
#define DPP_SHR1 0x111
#define DPP_SHR2 0x112
template <int CTRL> __device__ __forceinline__ float dppf(float old, float src) {
    return __builtin_bit_cast(float, __builtin_amdgcn_update_dpp(__builtin_bit_cast(int, old), __builtin_bit_cast(int, src), CTRL, 0xf, 0xf, false));
}
struct EpiConvGlu {
    static constexpr bool PERM = true, AFTER_DRAIN = false, PERMA = true;
    bf16* hm; const float* ss1; const float* conv_w; const float* conv_b; LAS unsigned char* halo; float* ub;
    __device__ __forceinline__ void operator()(const f32x4 (&acc)[2][2][4][2], const Unit& u, int wr, int wc, int fr, int fq) const {
        LAS f32x4* H = (LAS f32x4*)halo;
        const int grow0 = BM * u.pm + wr * 64 + 4 * fr;
        float rs[2][4];
#pragma unroll
        for (int ai = 0; ai < 2; ++ai) { const f32x4 sv = *(const f32x4*)(ss1 + grow0 + ai * HALF);
#pragma unroll
            for (int m = 0; m < 4; ++m) rs[ai][m] = __builtin_amdgcn_rsqf(sv[m] * (1.f / D) + EPS); }
        if (fr == 15) {
#pragma unroll
            for (int ai = 0; ai < 2; ++ai)
#pragma unroll
                for (int bj = 0; bj < 2; ++bj)
#pragma unroll
                    for (int n = 0; n < 2; ++n)
#pragma unroll
                        for (int mm = 0; mm < 2; ++mm) H[((((ai * 2 + wr) * 2 + mm) * 4 + wc) * 4 + fq) * 4 + bj * 2 + n] = acc[ai][bj][2 + mm][n] * rs[ai][2 + mm];
        }
        { const int ucol = u.pn * BM + wc * 32 + 8 * fq;
          if (wr == 0 && fr == 0) {
#pragma unroll
              for (int bj = 0; bj < 2; ++bj)
#pragma unroll
                  for (int n = 0; n < 2; ++n)
#pragma unroll
                      for (int mm = 0; mm < 2; ++mm) *(f32x4*)(ub + ((size_t)u.pm * 4 + mm) * NUP + ucol + bj * HALF + 4 * n) = acc[0][bj][mm][n] * rs[0][mm]; }
          if (wr == 1 && fr == 15) {
#pragma unroll
              for (int bj = 0; bj < 2; ++bj)
#pragma unroll
                  for (int n = 0; n < 2; ++n)
#pragma unroll
                      for (int mm = 0; mm < 2; ++mm) *(f32x4*)(ub + ((size_t)u.pm * 4 + 2 + mm) * NUP + ucol + bj * HALF + 4 * n) = acc[1][bj][2 + mm][n] * rs[1][2 + mm]; } }
        const int gc0 = u.pn * 128 + wc * 32 + 8 * fq;
        f32x4 w0[2], w1[2], w2[2], cb[2];
#pragma unroll
        for (int bj = 0; bj < 2; ++bj) { const int c = gc0 + bj * DFF; w0[bj] = *(const f32x4*)(conv_w + c); w1[bj] = *(const f32x4*)(conv_w + NUP + c); w2[bj] = *(const f32x4*)(conv_w + 2 * NUP + c); cb[bj] = *(const f32x4*)(conv_b + c); }
        asm volatile("s_waitcnt lgkmcnt(0)\n\ts_barrier" ::: "memory");
        f32x4 w0b[2], w1b[2], w2b[2], cbb[2];
        v2u wsave[2][4];
#pragma unroll
        for (int n = 0; n < 2; ++n) {
            const int gc = gc0 + 4 * n;
            if (n == 1) {
#pragma unroll
                for (int bj = 0; bj < 2; ++bj) { w0[bj] = w0b[bj]; w1[bj] = w1b[bj]; w2[bj] = w2b[bj]; cb[bj] = cbb[bj]; }
            }
#pragma unroll
            for (int ai = 0; ai < 2; ++ai) {
                const int blk = ai * 2 + wr;
                if (n == 0 && ai == 1) {
#pragma unroll
                    for (int bj = 0; bj < 2; ++bj) { const int c = gc0 + 4 + bj * DFF; w0b[bj] = *(const f32x4*)(conv_w + c); w1b[bj] = *(const f32x4*)(conv_w + NUP + c); w2b[bj] = *(const f32x4*)(conv_w + 2 * NUP + c); cbb[bj] = *(const f32x4*)(conv_b + c); }
                }
                f32x4 y[2][4];
#pragma unroll
                for (int bj = 0; bj < 2; ++bj) {
                    f32x4 o0 = (f32x4){0.f, 0.f, 0.f, 0.f}, o1 = o0;
                    if (blk > 0) { o0 = H[(((((blk - 1) * 2 + 0) * 4 + wc) * 4 + fq) * 4) + bj * 2 + n]; o1 = H[(((((blk - 1) * 2 + 1) * 4 + wc) * 4 + fq) * 4) + bj * 2 + n]; }
                    const f32x4 x0 = acc[ai][bj][0][n] * rs[ai][0], x1 = acc[ai][bj][1][n] * rs[ai][1], x2 = acc[ai][bj][2][n] * rs[ai][2], x3 = acc[ai][bj][3][n] * rs[ai][3];
                    f32x4 xm1, xm2;
#pragma unroll
                    for (int e = 0; e < 4; ++e) { xm1[e] = dppf<DPP_SHR1>(o1[e], x3[e]); xm2[e] = dppf<DPP_SHR1>(o0[e], x2[e]); }
                    y[bj][0] = cb[bj] + w2[bj] * x0 + w1[bj] * xm1 + w0[bj] * xm2;
                    y[bj][1] = cb[bj] + w2[bj] * x1 + w1[bj] * x0 + w0[bj] * xm1;
                    y[bj][2] = cb[bj] + w2[bj] * x2 + w1[bj] * x1 + w0[bj] * x0;
                    y[bj][3] = cb[bj] + w2[bj] * x3 + w1[bj] * x2 + w0[bj] * x1;
                }
#pragma unroll
                for (int m = 0; m < 4; ++m) {
                    const int grow = grow0 + ai * HALF + m;
                    const pg8::f32x2 ga = pg8::gelu_pk((pg8::f32x2){y[0][m][0], y[0][m][1]}), gb = pg8::gelu_pk((pg8::f32x2){y[0][m][2], y[0][m][3]});
                    v2u w; w.x = pk2(ga.x * y[1][m][0], ga.y * y[1][m][1]); w.y = pk2(gb.x * y[1][m][2], gb.y * y[1][m][3]);
                    if (n == 0) wsave[ai][m] = w; else { const v4u o = (v4u){wsave[ai][m].x, wsave[ai][m].y, w.x, w.y}; *(v4u*)(hm + (size_t)grow * DFF + gc0) = o; }
                }
            }
        }
    }
};
__device__ __forceinline__ void up_fixup(const float* ub, const float* conv_w, const float* conv_b, bf16* hm, int G, int tid0) {
    int tid_ = tid0; asm volatile("" : "+v"(tid_));
    for (int idx = blockIdx.x * NTHR + tid_; idx < 128 * 2 * DFF; idx += G * NTHR) {
        const int gc = idx % DFF, rr = (idx / DFF) & 1, pm = idx / (2 * DFF);
        if ((pm & 31) == 0) continue;
        const int ig = (gc >> 7) * 256 + (gc & 127);
        float y[2];
#pragma unroll
        for (int sd = 0; sd < 2; ++sd) {
            const int col = ig + sd * 128, c = gc + sd * DFF;
            const float um2 = ub[((size_t)(pm - 1) * 4 + 2) * NUP + col], um1 = ub[((size_t)(pm - 1) * 4 + 3) * NUP + col], u0 = ub[((size_t)pm * 4 + 0) * NUP + col], u1 = ub[((size_t)pm * 4 + 1) * NUP + col];
            const float w0 = conv_w[c], w1 = conv_w[NUP + c], w2 = conv_w[2 * NUP + c];
            y[sd] = conv_b[c] + (rr == 0 ? (w2 * u0 + w1 * um1 + w0 * um2) : (w2 * u1 + w1 * u0 + w0 * um1));
        }
        const float gl = 0.5f * y[0] * (1.0f + erff(y[0] * 0.70710678118654752f));
        hm[(size_t)(BM * pm + rr) * DFF + gc] = (bf16)f2bf(gl * y[1]);
    }
}

#define LBAR() asm volatile("s_waitcnt lgkmcnt(0)\n\ts_barrier" ::: "memory")
__device__ __forceinline__ void hgrn_tile_load(const bf16* T, int u, int tid, v4u (&r)[2]) {
    const int bh = u >> 7, c = u & 127, b = bh >> 3, h = bh & 7;
    const bf16* base = T + ((size_t)b * SEQ + c * 64) * D + h * 128;
#pragma unroll
    for (int j = 0; j < 2; ++j) { const int p = tid + 512 * j; r[j] = *(const v4u*)(base + (size_t)(p >> 4) * D + (p & 15) * 8); }
}
__device__ __forceinline__ void hgrn_tile_stage(LAS bf16* R, int tid, const v4u (&r)[2]) {
#pragma unroll
    for (int j = 0; j < 2; ++j) { const int p = tid + 512 * j; *(LAS v4u*)(R + (p >> 4) * 136 + (p & 15) * 8) = r[j]; }
}
__device__ __forceinline__ void hgrn_block_read(const LAS bf16* R, int kp, int part, unsigned (&w)[8]) {
#pragma unroll
    for (int j = 0; j < 8; ++j) w[j] = *(const LAS unsigned*)(R + (8 * part + j) * 136 + 2 * kp);
}
__device__ __forceinline__ void hgrn_vt_store2(const unsigned (&w)[8], LAS bf16* VT, int kp, int part) {
    v4u lo, hi;
    lo.x = (w[0] & 0xffffu) | (w[1] << 16); lo.y = (w[2] & 0xffffu) | (w[3] << 16); lo.z = (w[4] & 0xffffu) | (w[5] << 16); lo.w = (w[6] & 0xffffu) | (w[7] << 16);
    hi.x = (w[0] >> 16) | (w[1] & 0xffff0000u); hi.y = (w[2] >> 16) | (w[3] & 0xffff0000u); hi.z = (w[4] >> 16) | (w[5] & 0xffff0000u); hi.w = (w[6] >> 16) | (w[7] & 0xffff0000u);
    *(LAS v4u*)(VT + (2 * kp) * 72 + 8 * part) = lo; *(LAS v4u*)(VT + (2 * kp + 1) * 72 + 8 * part) = hi;
}
__device__ __forceinline__ void hgrn_pass_a(LAS unsigned char* lds, const bf16* HLF, const bf16* HI, bf16* LS, float* DK, int G, int tid0) {
    int tid_ = tid0; asm volatile("" : "+v"(tid_)); const int tid = tid_, lane = tid & 63, wave = tid >> 6, kp = lane, part = wave;
    LAS bf16* KT = (LAS bf16*)lds;
    LAS bf16* VT = (LAS bf16*)(lds + 18432);
    LAS float* SM = (LAS float*)(lds + 36864);
    LAS bf16* RF = (LAS bf16*)(lds + 40960);
    LAS bf16* RV = (LAS bf16*)(lds + 58368);
    v4u rf[2], rv[2];
    if ((int)blockIdx.x < 4096) { hgrn_tile_load(HLF, blockIdx.x, tid, rf); hgrn_tile_load(HI, blockIdx.x, tid, rv); }
    for (int u = blockIdx.x; u < 4096; u += G) {
        hgrn_tile_stage(RF, tid, rf); hgrn_tile_stage(RV, tid, rv);
        if (u + G < 4096) { hgrn_tile_load(HLF, u + G, tid, rf); hgrn_tile_load(HI, u + G, tid, rv); }
        LBAR();
        unsigned wf[8], wv[8];
        hgrn_block_read(RF, kp, part, wf); hgrn_block_read(RV, kp, part, wv);
        float l0[8], l1[8], b0[8], b1[8]; float r0 = 0.f, r1 = 0.f;
#pragma unroll
        for (int j = 0; j < 8; ++j) { l0[j] = bflo(wf[j]); l1[j] = bfhi(wf[j]); r0 += l0[j]; r1 += l1[j]; b0[j] = r0; b1[j] = r1; }
        *(LAS f32x2v*)(SM + part * 128 + 2 * kp) = (f32x2v){r0, r1};
        hgrn_vt_store2(wv, VT, kp, part);
        LBAR();
        float t0 = 0.f, t1 = 0.f, p0 = 0.f, p1 = 0.f;
#pragma unroll
        for (int p = 0; p < 8; ++p) { const f32x2v sp = *(const LAS f32x2v*)(SM + p * 128 + 2 * kp); t0 += sp.x; t1 += sp.y; if (p < part) { p0 += sp.x; p1 += sp.y; } }
        unsigned k0w[4], k1w[4];
#pragma unroll
        for (int j = 0; j < 8; j += 2) {
            k0w[j >> 1] = pk2((1.f - fexp(l0[j])) * fexp(t0 - (p0 + b0[j])), (1.f - fexp(l0[j + 1])) * fexp(t0 - (p0 + b0[j + 1])));
            k1w[j >> 1] = pk2((1.f - fexp(l1[j])) * fexp(t1 - (p1 + b1[j])), (1.f - fexp(l1[j + 1])) * fexp(t1 - (p1 + b1[j + 1])));
        }
        *(LAS v4u*)(KT + (2 * kp) * 72 + 8 * part) = (v4u){k0w[0], k0w[1], k0w[2], k0w[3]}; *(LAS v4u*)(KT + (2 * kp + 1) * 72 + 8 * part) = (v4u){k1w[0], k1w[1], k1w[2], k1w[3]};
        if (part == 0) *(f32x2v*)(DK + (size_t)u * 128 + 2 * kp) = (f32x2v){fexp(t0), fexp(t1)};
        LBAR();
        const int r = lane & 31, hh = lane >> 5, vi = wave >> 1;
#pragma unroll
        for (int q = 0; q < 2; ++q) {
            const int kj = 2 * (wave & 1) + q; f32x16 acc = {};
#pragma unroll
            for (int ks = 0; ks < 4; ++ks) {
                const bf16x8 a = *(const LAS bf16x8*)(KT + (32 * kj + r) * 72 + 16 * ks + 8 * hh);
                const bf16x8 bb = *(const LAS bf16x8*)(VT + (32 * vi + r) * 72 + 16 * ks + 8 * hh);
                acc = __builtin_amdgcn_mfma_f32_32x32x16_bf16(a, bb, acc, 0, 0, 0);
            }
            bf16* dst = LS + (size_t)u * 16384 + (size_t)(32 * vi + r) * 128 + 32 * kj + 4 * hh;
#pragma unroll
            for (int g = 0; g < 4; ++g) { v2u w; w.x = pk2c(acc[4 * g], acc[4 * g + 1]); w.y = pk2c(acc[4 * g + 2], acc[4 * g + 3]); *(v2u*)(dst + 8 * g) = w; }
        }
        LBAR();
    }
}
__device__ __forceinline__ void hgrn_pass_b(unsigned* LS32, const float* DK, int G, int tid0) {
    int tid_ = tid0; asm volatile("" : "+v"(tid_)); const int gt = blockIdx.x * NTHR + tid_, NG = G * NTHR;
    for (int p = gt; p < 32 * 8192; p += NG) {
        const int bh = p >> 13, e2 = p & 8191, k = 2 * (e2 & 63);
        unsigned* ls = LS32 + (size_t)bh * 128 * 8192 + e2;
        const float* dk = DK + (size_t)bh * 128 * 128 + k;
        float s0 = 0.f, s1 = 0.f;
        for (int c0 = 0; c0 < 128; c0 += 8) {
            unsigned w[8]; float d0[8], d1[8];
#pragma unroll
            for (int i = 0; i < 8; ++i) { w[i] = ls[(size_t)(c0 + i) * 8192]; const float2 d = *(const float2*)(dk + (size_t)(c0 + i) * 128); d0[i] = d.x; d1[i] = d.y; }
#pragma unroll
            for (int i = 0; i < 8; ++i) { ls[(size_t)(c0 + i) * 8192] = pk2(s0, s1); s0 = d0[i] * s0 + bflo(w[i]); s1 = d1[i] * s1 + bfhi(w[i]); }
        }
    }
}
__device__ __forceinline__ void hgrn_pass_c(LAS unsigned char* lds, bf16* HQ, const bf16* HLF, const bf16* HI, const bf16* HG, const bf16* LS, const float* gnorm, int G, int tid0) {
    int tid_ = tid0; asm volatile("" : "+v"(tid_)); const int tid = tid_, lane = tid & 63, wave = tid >> 6, kp = lane, part = wave;
    LAS bf16* QT = (LAS bf16*)lds;
    LAS bf16* KT2 = (LAS bf16*)(lds + 17408);
    LAS bf16* VT = (LAS bf16*)(lds + 34816);
    LAS float* SM = (LAS float*)(lds + 53248);
    LAS bf16* RF = (LAS bf16*)(lds + 57344);
    LAS bf16* RQ = (LAS bf16*)(lds + 74752);
    LAS bf16* RV = (LAS bf16*)(lds + 92160);
    LAS float* OL = (LAS float*)(lds + 57344);
    const int r = lane & 31, hh = lane >> 5, ti = wave & 1, vj = wave >> 1;
    v4u rf[2], rq[2], rv[2];
    if ((int)blockIdx.x < 4096) { hgrn_tile_load(HLF, blockIdx.x, tid, rf); hgrn_tile_load(HQ, blockIdx.x, tid, rq); hgrn_tile_load(HI, blockIdx.x, tid, rv); }
    for (int u = blockIdx.x; u < 4096; u += G) {
        const int bh = u >> 7, c = u & 127, b = bh >> 3, h = bh & 7;
        const size_t row0 = (size_t)b * SEQ + c * 64;
        hgrn_tile_stage(RF, tid, rf); hgrn_tile_stage(RQ, tid, rq); hgrn_tile_stage(RV, tid, rv);
        bf16x8 sfr[8];
        { const bf16* Sg = LS + (size_t)u * 16384 + (size_t)(32 * vj + r) * 128 + 8 * hh;
#pragma unroll
          for (int ks = 0; ks < 8; ++ks) sfr[ks] = *(const bf16x8*)(Sg + 16 * ks); }
        const size_t goff = (row0 + (tid >> 3)) * D + h * 128 + 16 * (tid & 7);
        const v4u g0 = *(const v4u*)(HG + goff), g1 = *(const v4u*)(HG + goff + 8);
        if (u + G < 4096) { hgrn_tile_load(HLF, u + G, tid, rf); hgrn_tile_load(HQ, u + G, tid, rq); hgrn_tile_load(HI, u + G, tid, rv); }
        LBAR();
        unsigned wf[8], wq[8];
        { unsigned wv[8]; hgrn_block_read(RV, kp, part, wv); hgrn_vt_store2(wv, VT, kp, part); }
        hgrn_block_read(RF, kp, part, wf); hgrn_block_read(RQ, kp, part, wq);
        float l0[8], l1[8], b0[8], b1[8]; float r0 = 0.f, r1 = 0.f;
#pragma unroll
        for (int j = 0; j < 8; ++j) { l0[j] = bflo(wf[j]); l1[j] = bfhi(wf[j]); r0 += l0[j]; r1 += l1[j]; b0[j] = r0; b1[j] = r1; }
        *(LAS f32x2v*)(SM + part * 128 + 2 * kp) = (f32x2v){r0, r1};
        LBAR();
        float p0 = 0.f, p1 = 0.f;
#pragma unroll
        for (int p = 0; p < 7; ++p) { const f32x2v sp = *(const LAS f32x2v*)(SM + p * 128 + 2 * kp); if (p < part) { p0 += sp.x; p1 += sp.y; } }
#pragma unroll
        for (int j = 0; j < 8; ++j) {
            const float bb0 = p0 + b0[j], bb1 = p1 + b1[j];
            *(LAS unsigned*)(QT + (8 * part + j) * 136 + 2 * kp) = pk2(bflo(wq[j]) * fexp(bb0), bfhi(wq[j]) * fexp(bb1));
            *(LAS unsigned*)(KT2 + (8 * part + j) * 136 + 2 * kp) = pk2((1.f - fexp(l0[j])) * fexp(-bb0), (1.f - fexp(l1[j])) * fexp(-bb1));
        }
        LBAR();
        bf16x8 pa[2][2];
#pragma unroll
        for (int sj = 0; sj < 2; ++sj) { pa[sj][0] = (bf16x8){0, 0, 0, 0, 0, 0, 0, 0}; pa[sj][1] = pa[sj][0]; }
#pragma unroll
        for (int sj = 0; sj < 2; ++sj) {
            if (sj <= ti) {
                f32x16 x = {};
#pragma unroll
                for (int ks = 0; ks < 8; ++ks) {
                    const bf16x8 a = *(const LAS bf16x8*)(KT2 + (32 * sj + r) * 136 + 16 * ks + 8 * hh);
                    const bf16x8 bq = *(const LAS bf16x8*)(QT + (32 * ti + r) * 136 + 16 * ks + 8 * hh);
                    x = __builtin_amdgcn_mfma_f32_32x32x16_bf16(a, bq, x, 0, 0, 0);
                }
                if (sj == ti) {
#pragma unroll
                    for (int i = 0; i < 16; ++i) if (crow(i, hh) > r) x[i] = 0.f;
                }
#pragma unroll
                for (int s2 = 0; s2 < 2; ++s2) { v4u pw; pw.x = pk2c(x[8 * s2], x[8 * s2 + 1]); pw.y = pk2c(x[8 * s2 + 2], x[8 * s2 + 3]); pw.z = pk2c(x[8 * s2 + 4], x[8 * s2 + 5]); pw.w = pk2c(x[8 * s2 + 6], x[8 * s2 + 7]);
                    pa[sj][s2] = __builtin_bit_cast(bf16x8, pw); }
            }
        }
        f32x16 o = {};
#pragma unroll
        for (int ks = 0; ks < 8; ++ks) {
            const bf16x8 a = *(const LAS bf16x8*)(QT + (32 * ti + r) * 136 + 16 * ks + 8 * hh);
            o = __builtin_amdgcn_mfma_f32_32x32x16_bf16(a, sfr[ks], o, 0, 0, 0);
        }
#pragma unroll
        for (int sj = 0; sj < 2; ++sj) {
            if (sj <= ti) {
#pragma unroll
                for (int s2 = 0; s2 < 2; ++s2) {
                    const LAS bf16* vp = VT + (32 * vj + r) * 72 + 32 * sj + 16 * s2 + 4 * hh;
                    const s16x4 lo = *(const LAS s16x4*)vp, hi4 = *(const LAS s16x4*)(vp + 8);
                    const bf16x8 pb = (bf16x8){lo[0], lo[1], lo[2], lo[3], hi4[0], hi4[1], hi4[2], hi4[3]};
                    o = __builtin_amdgcn_mfma_f32_32x32x16_bf16(pa[sj][s2], pb, o, 0, 0, 0);
                }
            }
        }
#pragma unroll
        for (int i = 0; i < 16; ++i) OL[(32 * ti + crow(i, hh)) * 132 + 32 * vj + r] = o[i];
        LBAR();
        {
            const int t = tid >> 3, vp = tid & 7;
            f32x4 ov[4]; float ss = 0.f;
#pragma unroll
            for (int q = 0; q < 4; ++q) { ov[q] = *(const LAS f32x4*)(OL + t * 132 + 16 * vp + 4 * q); ss += (ov[q][0] * ov[q][0] + ov[q][1] * ov[q][1]) + (ov[q][2] * ov[q][2] + ov[q][3] * ov[q][3]); }
            ss += __shfl_xor(ss, 1); ss += __shfl_xor(ss, 2); ss += __shfl_xor(ss, 4);
            const float rstd = 1.0f / sqrtf(ss * (1.f / 128.f) + EPS);
            const size_t off = goff;
            const f32x4* gn = (const f32x4*)(gnorm + 16 * vp);
            const f32x4 n0 = gn[0], n1 = gn[1], n2 = gn[2], n3 = gn[3];
            v4u w0, w1;
            w0.x = pk2(ov[0][0] * rstd * n0[0] * bflo(g0.x), ov[0][1] * rstd * n0[1] * bfhi(g0.x)); w0.y = pk2(ov[0][2] * rstd * n0[2] * bflo(g0.y), ov[0][3] * rstd * n0[3] * bfhi(g0.y));
            w0.z = pk2(ov[1][0] * rstd * n1[0] * bflo(g0.z), ov[1][1] * rstd * n1[1] * bfhi(g0.z)); w0.w = pk2(ov[1][2] * rstd * n1[2] * bflo(g0.w), ov[1][3] * rstd * n1[3] * bfhi(g0.w));
            w1.x = pk2(ov[2][0] * rstd * n2[0] * bflo(g1.x), ov[2][1] * rstd * n2[1] * bfhi(g1.x)); w1.y = pk2(ov[2][2] * rstd * n2[2] * bflo(g1.y), ov[2][3] * rstd * n2[3] * bfhi(g1.y));
            w1.z = pk2(ov[3][0] * rstd * n3[0] * bflo(g1.z), ov[3][1] * rstd * n3[1] * bfhi(g1.z)); w1.w = pk2(ov[3][2] * rstd * n3[2] * bflo(g1.w), ov[3][3] * rstd * n3[3] * bfhi(g1.w));
            *(v4u*)(HQ + off) = w0; *(v4u*)(HQ + off + 8) = w1;
        }
        LBAR();
    }
}
__device__ __forceinline__ void final_norm(float* out, const bf16* h2, const float* ss2, const float* g, int G, int tid0) {
    int tid_ = tid0; asm volatile("" : "+v"(tid_)); const int tid = tid_, lane = tid & 63, wave = tid >> 6;
    const int gw = blockIdx.x * NWAVES + wave, NGW = G * NWAVES;
    f32x4 gm[4];
#pragma unroll
    for (int j = 0; j < 2; ++j) { gm[2 * j] = *(const f32x4*)(g + 512 * j + 8 * lane); gm[2 * j + 1] = *(const f32x4*)(g + 512 * j + 8 * lane + 4); }
    v4u vn[2]; float sn = 1.f;
    if (gw < M) { const v4u* xr = (const v4u*)(h2 + (size_t)gw * D) + lane; sn = ss2[gw]; vn[0] = xr[0]; vn[1] = xr[64]; }
    for (int m = gw; m < M; m += NGW) {
        const v4u v0 = vn[0], v1 = vn[1]; const float sc = sn;
        if (m + NGW < M) { const v4u* xr = (const v4u*)(h2 + (size_t)(m + NGW) * D) + lane; sn = ss2[m + NGW]; vn[0] = xr[0]; vn[1] = xr[64]; }
        const float rstd = 1.0f / sqrtf(sc * (1.f / D) + EPS);
        float* orow = out + (size_t)m * D + 8 * lane;
        *(f32x4*)(orow) = (f32x4){bflo(v0.x), bfhi(v0.x), bflo(v0.y), bfhi(v0.y)} * rstd * gm[0];
        *(f32x4*)(orow + 4) = (f32x4){bflo(v0.z), bfhi(v0.z), bflo(v0.w), bfhi(v0.w)} * rstd * gm[1];
        *(f32x4*)(orow + 512) = (f32x4){bflo(v1.x), bfhi(v1.x), bflo(v1.y), bfhi(v1.y)} * rstd * gm[2];
        *(f32x4*)(orow + 516) = (f32x4){bflo(v1.z), bfhi(v1.z), bflo(v1.w), bfhi(v1.w)} * rstd * gm[3];
    }
}

#define XB_TMO      128
#define XB_XCNT(j)  (256  + 64 * (j))
#define XB_XSUB(j)  (1280 + 64 * (j))
#define XB_XGEN(j)  (2304 + 64 * (j))
#define XB_TOP      3328
#define XB_TOPGEN   3392
#define XCD_BAR_WORDS 3456
#define XB_SPIN_CAP (1u << 18)

__device__ __forceinline__ unsigned xb_ld(unsigned* p)              { return __hip_atomic_load(p, __ATOMIC_RELAXED, __HIP_MEMORY_SCOPE_AGENT); }
__device__ __forceinline__ unsigned xb_add(unsigned* p, unsigned v) { return __hip_atomic_fetch_add(p, v, __ATOMIC_RELAXED, __HIP_MEMORY_SCOPE_AGENT); }
__device__ __forceinline__ unsigned xb_xcc_id() { return (unsigned)__builtin_amdgcn_s_getreg((3 << 11) | 20) & 0xFu; }
#define XB_SPIN(cond, bar) do { unsigned _sp = 0; while (cond) { __builtin_amdgcn_s_sleep(1); \
    if ((++_sp & 255u) == 0u) { if (xb_ld(&(bar)[XB_TMO])) break; if (_sp > XB_SPIN_CAP) { atomicAdd(&(bar)[XB_TMO], 1u); break; } } } } while (0)

struct XcdBarrier {
    unsigned* bar; unsigned x;
    volatile LAS unsigned* st;
};

__device__ __forceinline__ XcdBarrier xcd_barrier_post(unsigned* bar, volatile LAS unsigned* st, int tid0) {
    XcdBarrier b; b.bar = bar; b.x = xb_xcc_id(); b.st = st;
    if (tid0 == 0) (void)xb_add(&bar[XB_XCNT(b.x)], 1u);
    return b;
}
__device__ __forceinline__ void xcd_barrier_complete(unsigned* bar, unsigned x, unsigned& nloc, unsigned& nx) {
    const unsigned G = gridDim.x * gridDim.y * gridDim.z;
    unsigned sum, cnt, mine, sp = 0u;
    for (;;) {
        sum = 0u; cnt = 0u; mine = 0u;
#pragma unroll
        for (unsigned j = 0; j < 16; ++j) { const unsigned c = xb_ld(&bar[XB_XCNT(j)]); sum += c; cnt += (c > 0u) ? 1u : 0u; mine = (j == x) ? c : mine; }
        if (sum == G) break;
        __builtin_amdgcn_s_sleep(1);
        if ((++sp & 255u) == 0u) { if (xb_ld(&bar[XB_TMO])) break; if (sp > XB_SPIN_CAP) { atomicAdd(&bar[XB_TMO], 1u); break; } }
    }
    nloc = mine > 0u ? mine : 1u; nx = cnt > 0u ? cnt : 1u;
}

__device__ __forceinline__ void xcd_barrier(const XcdBarrier& b, int tid0) {
    asm volatile("s_waitcnt vmcnt(0)" ::: "memory");
    __syncthreads();
    if (tid0 == 0) {
        unsigned* bar = b.bar;
        __builtin_amdgcn_s_waitcnt(0);
        unsigned nloc = b.st[0], nx = b.st[1];
        if (nloc == 0u) { xcd_barrier_complete(bar, b.x, nloc, nx); b.st[0] = nloc; b.st[1] = nx; }
        const unsigned old = xb_add(&bar[XB_XSUB(b.x)], 1u);
        const unsigned gen = old / nloc;
        if (old + 1u == (gen + 1u) * nloc) {
            __builtin_amdgcn_fence(__ATOMIC_RELEASE, "agent");
            asm volatile("s_waitcnt vmcnt(0)" ::: "memory");
            const unsigned og = xb_add(&bar[XB_TOP], 1u);
            const unsigned tg = og / nx;
            if (og + 1u == (tg + 1u) * nx) xb_add(&bar[XB_TOPGEN], 1u);
            else XB_SPIN(xb_ld(&bar[XB_TOPGEN]) == tg, bar);
            __builtin_amdgcn_fence(__ATOMIC_ACQUIRE, "agent");
            xb_add(&bar[XB_XGEN(b.x)], 1u);
            asm volatile("s_waitcnt vmcnt(0)" ::: "memory");
        } else {
            XB_SPIN(xb_ld(&bar[XB_XGEN(b.x)]) == gen, bar);
            __builtin_amdgcn_fence(__ATOMIC_ACQUIRE, "agent");
            asm volatile("s_waitcnt vmcnt(0)" ::: "memory");
        }
    }
    __syncthreads();
}

__device__ __forceinline__ int lane_id_opaque() { int l; asm volatile("v_mbcnt_lo_u32_b32 %0, -1, 0\n\tv_mbcnt_hi_u32_b32 %0, -1, %0" : "=v"(l)); return l; }
struct Args { const float* in[15]; float* out; unsigned char* ws; int ph_lo, ph_hi; };
#ifndef NOPH0
#define NOPH0 0
#endif
#ifndef NOPH1
#define NOPH1 0
#endif
#ifndef NOPH2
#define NOPH2 0
#endif
#ifndef NOPH3
#define NOPH3 0
#endif
#ifndef NOPH4
#define NOPH4 0
#endif
#ifndef NOPH5
#define NOPH5 0
#endif
#ifndef NOPH6
#define NOPH6 0
#endif
#ifndef NOPH7
#define NOPH7 0
#endif
#ifndef NOPH8
#define NOPH8 0
#endif
#ifndef NOPH9
#define NOPH9 0
#endif
#ifndef NOPH10
#define NOPH10 0
#endif
#ifndef NOPH11
#define NOPH11 0
#endif
#ifndef NOPH12
#define NOPH12 0
#endif
constexpr int N_PHASES = 13;
#ifndef MK_ONE_LAUNCH
#define MK_ONE_LAUNCH 1
#endif

__global__ void __launch_bounds__(NTHR, 2) hybrid_fwd(Args args) {
    extern __shared__ __attribute__((aligned(16))) unsigned char lds_raw[];
    LAS unsigned char* lds = (LAS unsigned char*)lds_raw;
    const int G = gridDim.x;
    const int wave_s = __builtin_amdgcn_readfirstlane((int)threadIdx.x >> 6);
#define KTID() (wave_s * 64 + lane_id_opaque())
    if (args.ph_lo < 0) cg::this_grid().sync();
    Ptrs P;
    P.x = args.in[0]; P.norm_mix = args.in[1]; P.w_in = args.in[2]; P.fbias = args.in[3]; P.lblog = args.in[4]; P.hg_norm = args.in[5];
    P.w_a = args.in[6]; P.w_b = args.in[7]; P.w_o = args.in[8]; P.norm_ffn = args.in[9]; P.w_up = args.in[10]; P.conv_w = args.in[11]; P.conv_b = args.in[12];
    P.w_dn = args.in[13]; P.norm_final = args.in[14]; P.out = args.out; P.ws = args.ws;
    unsigned char* ws = args.ws;
    bf16* Wt_in = (bf16*)(ws + WS_WIN);
    bf16* S0 = (bf16*)(ws + WS_SLOT0); bf16* S1 = (bf16*)(ws + WS_SLOT0 + SLOT); bf16* S2 = (bf16*)(ws + WS_SLOT0 + 2 * SLOT); bf16* S3 = (bf16*)(ws + WS_SLOT0 + 3 * SLOT);
    bf16* S4 = (bf16*)(ws + WS_SLOT0 + 4 * SLOT); bf16* S5 = (bf16*)(ws + WS_SLOT0 + 5 * SLOT); bf16* S6 = (bf16*)(ws + WS_SLOT0 + 6 * SLOT); bf16* D0 = (bf16*)args.out;
    float* SS1 = (float*)(ws + WS_SS1); float* SS2 = (float*)(ws + WS_SS2);
    const int lo = args.ph_lo, hi = args.ph_hi;
#define IN(k) (lo <= (k) && (k) < hi)
    {   volatile LAS unsigned* barw = (volatile LAS unsigned*)(lds + BARW_OFF);
        if (KTID() < 2) barw[KTID()] = 0u;
        __syncthreads();
        if (hi - lo > 1) (void)xcd_barrier_post((unsigned*)(ws + WS_BAR), barw, KTID()); }
#define SEAM(k) do { if (IN(k) && IN((k) + 1)) { { XcdBarrier b_; b_.bar = (unsigned*)(args.ws + WS_BAR); b_.x = xb_xcc_id(); b_.st = (volatile LAS unsigned*)(lds + BARW_OFF); xcd_barrier(b_, KTID()); } } } while (0)

#ifndef PROBE_LO
#define PROBE_LO 99
#define PROBE_HI 99
#endif
    unsigned long long pr_acc = 0, pr_t0 = 0;
#define PR_BEGIN(k) do { if ((k) == PROBE_LO) pr_t0 = __builtin_amdgcn_s_memrealtime(); } while (0)
#define PR_END(k) do { if ((k) == PROBE_HI) pr_acc = __builtin_amdgcn_s_memrealtime() - pr_t0; } while (0)
    PR_BEGIN(0);
    if (IN(0) && !NOPH0) { p0_prologue(lds, P, G, KTID()); }
    SEAM(0);
    PR_END(0);
    PR_BEGIN(1);
    if (IN(1) && !NOPH1) {
        p1_cscan(lds, P, KTID());
        pg8::Gemm g{S0, Wt_in + (size_t)4096 * D, M, 3072, D, 0}; pg8::StaticOrder S; S.init(M, 3072, G, (int)blockIdx.x);
        EpiProj E{S1, S2, S3, S3, 0, 0, 0, 0, attn_body::C2, nullptr};
        pg8::gemm_phase<EpiProj, pg8::StaticOrder, true, true>(lds, g, S, E, KTID());
    }
    SEAM(1);
    PR_END(1);
    PR_BEGIN(2);
    if (IN(2) && !NOPH2) {
        const attn_body::AttnTensors AT{(const attn_body::bf16*)S1, (const attn_body::bf16*)S2, (const attn_body::bf16*)S3, (attn_body::bf16*)S1, (const float*)(ws + WS_CL)};
        const attn_body::StaticOrder S(G, (int)blockIdx.x);
        attn_body::attn_phase<attn_body::StaticOrder>((char*)lds_raw, AT, S, KTID());
    }
    PR_END(2);
    PR_BEGIN(3);
    if (IN(3) && !NOPH3) {
        pg8::Gemm g{S0, Wt_in, M, 4096, D, 0}; pg8::StaticOrder S; S.init(M, 4096, G, (int)blockIdx.x);
        EpiProj E{S4, S5, S6, D0, 1, 2, 0, 1, 1.f, (const float*)(ws + WS_LBV)};
        pg8::gemm_phase<EpiProj, pg8::StaticOrder, true, true>(lds, g, S, E, KTID());
    }
    SEAM(3);
    PR_END(3);
    PR_BEGIN(4);
    if (IN(4) && !NOPH4) hgrn_pass_a(lds, S5, S6, S2, (float*)(ws + WS_DK), G, KTID());
    SEAM(4);
    PR_END(4);
    PR_BEGIN(5);
    if (IN(5) && !NOPH5) hgrn_pass_b((unsigned*)S2, (const float*)(ws + WS_DK), G, KTID());
    SEAM(5);
    PR_END(5);
    PR_BEGIN(6);
    if (IN(6) && !NOPH6) hgrn_pass_c(lds, S4, S5, S6, D0, S2, P.hg_norm, G, KTID());
    SEAM(6);
    PR_END(6);
    PR_BEGIN(7);
    if (IN(7) && !NOPH7) {
        pg8::Gemm g{S0, Wt_in + (size_t)7168 * D, M, 2048, D, 0}; pg8::StaticOrder S; S.init(M, 2048, G, (int)blockIdx.x);
        EpiProj E{S5, S6, S6, S6, 0, 0, 0, 0, 1.f, nullptr};
        pg8::gemm_phase<EpiProj, pg8::StaticOrder, true, true>(lds, g, S, E, KTID());
    }
    SEAM(7);
    PR_END(7);
    PR_BEGIN(8);
    if (IN(8) && !NOPH8) {
        { pg8::Gemm g{S4, (const bf16*)(ws + WS_WA), M, D, D, 0}; pg8::StaticOrder S; S.init(M, D, G, (int)blockIdx.x);
          EpiGate E{S5, nullptr, S5};
          pg8::gemm_phase<EpiGate, pg8::StaticOrder, true, true>(lds, g, S, E, KTID()); }
        asm volatile("s_waitcnt vmcnt(0)" ::: "memory"); __builtin_amdgcn_fence(__ATOMIC_ACQUIRE, "agent"); asm volatile("s_waitcnt vmcnt(0)" ::: "memory"); __syncthreads();
        { pg8::Gemm g{S1, (const bf16*)(ws + WS_WB), M, D, D, 0}; pg8::StaticOrder S; S.init(M, D, G, (int)blockIdx.x);
          EpiGate E{S6, S5, S6};
          pg8::gemm_phase<EpiGate, pg8::StaticOrder, true, true>(lds, g, S, E, KTID()); }
    }
    SEAM(8);
    PR_END(8);
    PR_BEGIN(9);
    if (IN(9) && !NOPH9) {
        pg8::Gemm g{S6, (const bf16*)(ws + WS_WO), M, D, D, 0}; pg8::StaticOrder S; S.init(M, D, G, (int)blockIdx.x);
        EpiResB E{P.x, nullptr, S0, SS1};
        pg8::gemm_phase<EpiResB, pg8::StaticOrder, true, true>(lds, g, S, E, KTID());
    }
    SEAM(9);
    PR_END(9);
    PR_BEGIN(10);
    if (IN(10) && !NOPH10) {
        pg8::Gemm g{S0, (const bf16*)(ws + WS_WUP), M, NUP, D, 0}; pg8::StaticOrder S; S.init(M, NUP, G, (int)blockIdx.x);
        EpiConvGlu E{S1, SS1, P.conv_w, P.conv_b, lds + HALO_OFF, (float*)S4};
        pg8::gemm_phase<EpiConvGlu, pg8::StaticOrder, true, true>(lds, g, S, E, KTID());
        if (hi - lo > 1) { XcdBarrier b_; b_.bar = (unsigned*)(args.ws + WS_BAR); b_.x = xb_xcc_id(); b_.st = (volatile LAS unsigned*)(lds + BARW_OFF); xcd_barrier(b_, KTID()); }
        up_fixup((const float*)S4, P.conv_w, P.conv_b, S1, G, KTID());
    }
    SEAM(10);
    PR_END(10);
    PR_BEGIN(11);
    if (IN(11) && !NOPH11) {
        pg8::Gemm g{S1, (const bf16*)(ws + WS_WDN), M, D, DFF, 0}; pg8::StaticOrder S; S.init(M, D, G, (int)blockIdx.x);
        EpiResB E{nullptr, S0, S0, SS2};
        pg8::gemm_phase<EpiResB, pg8::StaticOrder, true, true>(lds, g, S, E, KTID());
    }
    SEAM(11);
    PR_END(11);
    PR_BEGIN(12);
    if (IN(12) && !NOPH12) final_norm(P.out, S0, SS2, P.norm_final, G, KTID());
    PR_END(12);
    if (PROBE_LO != 99) { __syncthreads(); const unsigned long long te = __builtin_amdgcn_s_memrealtime(); while (__builtin_amdgcn_s_memrealtime() - te < 4ull * pr_acc) __builtin_amdgcn_s_sleep(8); }
#undef IN
#undef SEAM
}

extern "C" void kernel_launch(void* const* d_in, const int* in_sizes, int n_in, void* d_out, int out_size, void* d_ws, size_t ws_size, hipStream_t stream) {
    static int grid = 0;
    if (grid == 0) {
        if (n_in != 15 || in_sizes[0] != M * D || out_size != M * D || ws_size < WS_END) { fprintf(stderr, "kernel_launch: unexpected shapes / workspace (%d inputs, in0 %d, out %d, ws %zu < %zu)\n", n_in, n_in > 0 ? in_sizes[0] : -1, out_size, ws_size, (size_t)WS_END); grid = -1; return; }
        int dev = 0, cus = 0, per_cu = 0;
        if (hipGetDevice(&dev) != hipSuccess || hipDeviceGetAttribute(&cus, hipDeviceAttributeMultiprocessorCount, dev) != hipSuccess) { grid = -1; return; }
        if (hipFuncSetAttribute((const void*)hybrid_fwd, hipFuncAttributeMaxDynamicSharedMemorySize, LDS_BYTES) != hipSuccess) { fprintf(stderr, "kernel_launch: hipFuncSetAttribute failed\n"); grid = -1; return; }
        if (hipOccupancyMaxActiveBlocksPerMultiprocessor(&per_cu, (const void*)hybrid_fwd, NTHR, LDS_BYTES) != hipSuccess || per_cu < 1) per_cu = 1;
        (void)hipGetLastError();
        grid = cus;
    }
    if (grid < 0) return;
    if (hipMemsetAsync((char*)d_ws + WS_BAR, 0, BAR_BYTES, stream) != hipSuccess) { fprintf(stderr, "kernel_launch: memset failed\n"); return; }
    Args a{};
    for (int i = 0; i < 15; ++i) a.in[i] = (const float*)d_in[i];
    a.out = (float*)d_out; a.ws = (unsigned char*)d_ws;
#if MK_ONE_LAUNCH
    a.ph_lo = 0; a.ph_hi = N_PHASES;
    void* kargs[] = {&a};
    hipError_t e = hipLaunchCooperativeKernel((const void*)hybrid_fwd, dim3(grid), dim3(NTHR), kargs, LDS_BYTES, stream);
    if (e != hipSuccess) fprintf(stderr, "cooperative launch failed: %s (grid %d)\n", hipGetErrorString(e), grid);
#else
    for (int p = 0; p < N_PHASES; ++p) { a.ph_lo = p; a.ph_hi = p + 1; hipLaunchKernelGGL(hybrid_fwd, dim3(grid), dim3(NTHR), LDS_BYTES, stream, a); }
#endif
}
```
